# Optimizing an MI355X kernel written in HIP

```python
import jax, jax.numpy as jnp
from jax import lax
import numpy as np

D_MODEL = 2048
BATCH = 1
SEQ = 16384
DEPTH = 1

CHUNK = 64
RMS_EPS = 1e-5
A_HEADS = 4
A_QK = 128
A_V = 256
CONV_W = 4
B_HEADS = 8
B_HEAD_DIM = 128
Q_BLOCK = 128
N_EXPERTS = 32
TOP_K = 4
D_FF = 2048
SWIGLU_LIMIT = 7.0
SWIGLU_ALPHA = 1.702
MOE_BLOCK = 256

A_QK_W = A_HEADS * A_QK
A_V_W = A_HEADS * A_V
B_W = B_HEADS * B_HEAD_DIM
IN_COLS = 2 * A_QK_W + 2 * A_V_W + 2 * A_HEADS + 3 * B_W
SPLITS = (A_QK_W, 2 * A_QK_W, 2 * A_QK_W + A_V_W, 2 * A_QK_W + 2 * A_V_W,
          2 * A_QK_W + 2 * A_V_W + 2 * A_HEADS, 2 * A_QK_W + 2 * A_V_W + 2 * A_HEADS + B_W,
          2 * A_QK_W + 2 * A_V_W + 2 * A_HEADS + 2 * B_W)

kernel_name = "hybrid_mlstm_stickbreaking_moe"


def rmsnorm(x, g):
    xf = x.astype(jnp.float32)
    y = xf * lax.rsqrt(jnp.mean(xf * xf, axis=-1, keepdims=True) + RMS_EPS)
    return (y * g.astype(jnp.float32)).astype(x.dtype)


def causal_dwconv(u, w, b):
    k_w, s = w.shape[0], u.shape[1]
    up = jnp.pad(u, ((0, 0), (k_w - 1, 0), (0, 0)))
    out = b
    for j in range(k_w):
        out = out + up[:, j:j + s, :] * w[j]
    return out


def mlstm(q, k, v, i_pre, f_pre):
    bn, s, h_n = q.shape[:3]
    nc = s // CHUNK

    def chunked(t):
        t = t.astype(jnp.float32).reshape((bn, nc, CHUNK) + t.shape[2:])
        return jnp.moveaxis(t, 3, 1)

    qc = chunked(q)
    kc = chunked(k) * (A_QK ** -0.5)
    vc = chunked(v)
    ig = chunked(i_pre)
    lf = jax.nn.log_sigmoid(chunked(f_pre))
    a = jnp.cumsum(lf, axis=-1)
    g = a[..., -1]

    w = g[..., None] - a + ig
    m_loc = jnp.max(w, axis=-1)
    e = jnp.exp(w - m_loc[..., None])
    c_loc = jnp.einsum('bhcl,bhclv,bhclk->bhcvk', e, vc, kc)
    n_loc = jnp.einsum('bhcl,bhclk->bhck', e, kc)

    def step(carry, xs):
        c_st, n_st, m_st = carry
        c_l, n_l, m_l, g_c = xs
        m_new = jnp.maximum(g_c + m_st, m_l)
        s_old = jnp.exp(g_c + m_st - m_new)
        s_new = jnp.exp(m_l - m_new)
        c_next = s_old[..., None, None] * c_st + s_new[..., None, None] * c_l
        n_next = s_old[..., None] * n_st + s_new[..., None] * n_l
        return (c_next, n_next, m_new), (c_st, n_st, m_st)

    init = (jnp.zeros((bn, h_n, A_V, A_QK), jnp.float32),
            jnp.zeros((bn, h_n, A_QK), jnp.float32),
            jnp.zeros((bn, h_n), jnp.float32))
    xs = (jnp.moveaxis(c_loc, 2, 0), jnp.moveaxis(n_loc, 2, 0),
          jnp.moveaxis(m_loc, 2, 0), jnp.moveaxis(g, 2, 0))
    _, (c_prev, n_prev, m_prev) = lax.scan(step, init, xs)
    c_prev = jnp.moveaxis(c_prev, 0, 2)
    n_prev = jnp.moveaxis(n_prev, 0, 2)
    m_prev = jnp.moveaxis(m_prev, 0, 2)

    m_inter = a + m_prev[..., None]
    causal = jnp.tril(jnp.ones((CHUNK, CHUNK), dtype=bool))
    d_log = a[..., :, None] - a[..., None, :] + ig[..., None, :]
    d_log = jnp.where(causal, d_log, -jnp.inf)
    m_t = jnp.maximum(m_inter, jnp.max(d_log, axis=-1))
    p = jnp.exp(d_log - m_t[..., None]) * jnp.einsum('bhctk,bhcsk->bhcts', qc, kc)
    s_inter = jnp.exp(m_inter - m_t)
    num = (s_inter[..., None] * jnp.einsum('bhcvk,bhctk->bhctv', c_prev, qc)
           + jnp.einsum('bhcts,bhcsv->bhctv', p, vc))
    den = s_inter * jnp.einsum('bhck,bhctk->bhct', n_prev, qc) + jnp.sum(p, axis=-1)
    h = num / jnp.maximum(jnp.abs(den), jnp.exp(-m_t))[..., None]
    return jnp.moveaxis(h, 1, 3).reshape(bn, s, h_n, A_V)


def head_rmsnorm(y, g):
    y = y * lax.rsqrt(jnp.mean(y * y, axis=-1, keepdims=True) + RMS_EPS)
    return y.reshape(y.shape[:2] + (-1,)) * g.astype(jnp.float32)


def stick_breaking(q, k, v):
    bn, s, h_n, d = q.shape
    nq = s // Q_BLOCK
    scale = d ** -0.5
    kf = k.astype(jnp.float32)
    vf = v.astype(jnp.float32)
    qb = jnp.moveaxis(q.astype(jnp.float32).reshape(bn, nq, Q_BLOCK, h_n, d), 1, 0)
    kpos = jnp.arange(s)

    def block(args):
        q_blk, blk = args
        qpos = blk * Q_BLOCK + jnp.arange(Q_BLOCK)
        z = jnp.einsum('bqhd,bshd->bhqs', q_blk, kf) * scale
        past = kpos[None, :] < qpos[:, None]
        log_beta = jax.nn.log_sigmoid(z)
        log_keep = jnp.where(past, jax.nn.log_sigmoid(-z), 0.0)
        rev = lax.cumsum(log_keep, axis=3, reverse=True)
        r = jnp.concatenate([rev[..., 1:], jnp.zeros_like(rev[..., :1])], axis=-1)
        att = jnp.where(past, jnp.exp(log_beta + r), 0.0)
        return jnp.einsum('bhqs,bshd->bqhd', att, vf)

    out = lax.map(block, (qb, jnp.arange(nq)))
    return jnp.moveaxis(out, 0, 1).reshape(bn, s, h_n * d)


def moe(h, w_router, b_router, w_gate_up, b_gate_up, w_down, b_down):
    bn, s, d = h.shape
    t_n = bn * s
    xt = h.reshape(t_n, d)
    logits = (xt @ w_router + b_router).astype(jnp.float32)
    top_val, top_idx = lax.top_k(logits, TOP_K)
    gates = jax.nn.softmax(top_val, axis=-1)
    p_n = t_n * TOP_K
    e_flat = top_idx.reshape(p_n)
    order = jnp.argsort(e_flat)
    e_sorted = e_flat[order]
    tok_sorted = order // TOP_K
    gate_sorted = gates.reshape(p_n)[order]
    counts = jnp.zeros((N_EXPERTS,), jnp.int32).at[e_flat].add(1)
    padded = (counts + MOE_BLOCK - 1) // MOE_BLOCK * MOE_BLOCK
    start = jnp.cumsum(counts) - counts
    pad_end = jnp.cumsum(padded)
    pad_start = pad_end - padded
    dest = pad_start[e_sorted] + jnp.arange(p_n) - start[e_sorted]
    nb = -(-p_n // MOE_BLOCK) + N_EXPERTS
    x_pad = jnp.zeros((nb * MOE_BLOCK, d), xt.dtype).at[dest].set(xt[tok_sorted])
    block_expert = jnp.minimum(
        jnp.searchsorted(pad_end, jnp.arange(nb) * MOE_BLOCK, side='right'), N_EXPERTS - 1)

    def expert_block(args):
        xb, e = args
        gu = xb @ w_gate_up[e] + b_gate_up[e]
        gate = jnp.minimum(gu[:, :D_FF], SWIGLU_LIMIT)
        up = jnp.clip(gu[:, D_FF:], -SWIGLU_LIMIT, SWIGLU_LIMIT)
        act = (up + 1.0) * gate * jax.nn.sigmoid(SWIGLU_ALPHA * gate)
        return act @ w_down[e] + b_down[e]

    y_pad = lax.map(expert_block, (x_pad.reshape(nb, MOE_BLOCK, d), block_expert))
    y_pad = y_pad.reshape(nb * MOE_BLOCK, d)
    y = jnp.zeros((t_n, d), jnp.float32).at[tok_sorted].add(
        gate_sorted[:, None] * y_pad[dest].astype(jnp.float32))
    return y.astype(h.dtype).reshape(bn, s, d)


def setup_inputs(seed: int = 0) -> dict:
    key = jax.random.key(seed)
    ks = jax.random.split(key, 24)
    n = lambda k, shape, sc: jax.random.normal(k, shape, jnp.float32) * sc
    i_bias = -2.0 + n(ks[4], (DEPTH, A_HEADS), 0.1)
    f_bias = jnp.linspace(3.0, 6.0, A_HEADS)[None, :] + n(ks[5], (DEPTH, A_HEADS), 0.1)
    return {
        "x": n(ks[0], (BATCH, SEQ, D_MODEL), 1.0),
        "norm_mix": 1.0 + n(ks[1], (DEPTH, D_MODEL), 0.02),
        "w_in": n(ks[2], (DEPTH, D_MODEL, IN_COLS), D_MODEL ** -0.5),
        "conv_w": n(ks[3], (DEPTH, CONV_W, 2 * A_QK_W), CONV_W ** -0.5),
        "conv_b": n(ks[6], (DEPTH, 2 * A_QK_W), 0.01),
        "b_gates_if": jnp.concatenate([i_bias, f_bias], axis=-1),
        "norm_head": 1.0 + n(ks[7], (DEPTH, A_V_W), 0.02),
        "w_proj_a": n(ks[8], (DEPTH, A_V_W, D_MODEL), A_V_W ** -0.5),
        "w_proj_b": n(ks[9], (DEPTH, B_W, D_MODEL), B_W ** -0.5),
        "w_merge_gate": n(ks[10], (DEPTH, D_MODEL, 2 * D_MODEL), D_MODEL ** -0.5),
        "b_merge_gate": n(ks[11], (DEPTH, 2 * D_MODEL), 0.01),
        "w_out": n(ks[12], (DEPTH, D_MODEL, D_MODEL), D_MODEL ** -0.5),
        "norm_ffn": 1.0 + n(ks[13], (DEPTH, D_MODEL), 0.02),
        "w_router": n(ks[14], (DEPTH, D_MODEL, N_EXPERTS), D_MODEL ** -0.5),
        "b_router": n(ks[15], (DEPTH, N_EXPERTS), 0.01),
        "w_gate_up": n(ks[16], (DEPTH, N_EXPERTS, D_MODEL, 2 * D_FF), D_MODEL ** -0.5),
        "b_gate_up": n(ks[17], (DEPTH, N_EXPERTS, 2 * D_FF), 0.01),
        "w_down": n(ks[18], (DEPTH, N_EXPERTS, D_FF, D_MODEL), D_FF ** -0.5),
        "b_down": n(ks[19], (DEPTH, N_EXPERTS, D_MODEL), 0.01),
        "norm_final": 1.0 + n(ks[20], (D_MODEL,), 0.02),
    }


def reference(x, norm_mix, w_in, conv_w, conv_b, b_gates_if, norm_head, w_proj_a, w_proj_b,
              w_merge_gate, b_merge_gate, w_out, norm_ffn, w_router, b_router, w_gate_up,
              b_gate_up, w_down, b_down, norm_final):
    bn, s, _ = x.shape
    for l in range(DEPTH):
        h = rmsnorm(x, norm_mix[l])
        proj = h @ w_in[l]
        a_q, a_k, a_v, a_o, a_if, b_q, b_k, b_v = jnp.split(proj, list(SPLITS), axis=-1)
        a_qk = jax.nn.silu(causal_dwconv(jnp.concatenate([a_q, a_k], axis=-1), conv_w[l], conv_b[l]))
        a_q, a_k = a_qk[..., :A_QK_W], a_qk[..., A_QK_W:]
        a_if = a_if + b_gates_if[l]
        y_a = mlstm(a_q.reshape(bn, s, A_HEADS, A_QK), a_k.reshape(bn, s, A_HEADS, A_QK),
                    a_v.reshape(bn, s, A_HEADS, A_V), a_if[..., :A_HEADS], a_if[..., A_HEADS:])
        y_a = (head_rmsnorm(y_a, norm_head[l]) * jax.nn.sigmoid(a_o.astype(jnp.float32))).astype(x.dtype)
        y_b = stick_breaking(b_q.reshape(bn, s, B_HEADS, B_HEAD_DIM),
                             b_k.reshape(bn, s, B_HEADS, B_HEAD_DIM),
                             b_v.reshape(bn, s, B_HEADS, B_HEAD_DIM)).astype(x.dtype)
        gates = jax.nn.sigmoid(h @ w_merge_gate[l] + b_merge_gate[l])
        mixed = (gates[..., :D_MODEL] * (y_a @ w_proj_a[l])
                 + gates[..., D_MODEL:] * (y_b @ w_proj_b[l]))
        x = x + mixed @ w_out[l]
        h = rmsnorm(x, norm_ffn[l])
        x = x + moe(h, w_router[l], b_router[l], w_gate_up[l], b_gate_up[l], w_down[l], b_down[l])
    return rmsnorm(x, norm_final)
```

```cpp
#include <hip/hip_runtime.h>
#include <cstdio>
#include <type_traits>

#define GAS __attribute__((address_space(1)))
#define LAS __attribute__((address_space(3)))
typedef unsigned short bf16;
typedef unsigned v4u __attribute__((ext_vector_type(4)));
typedef unsigned v2u __attribute__((ext_vector_type(2)));
typedef float f32x4 __attribute__((ext_vector_type(4)));
typedef float f32x2 __attribute__((ext_vector_type(2)));
typedef float f32x16 __attribute__((ext_vector_type(16)));
typedef short bf16x8 __attribute__((ext_vector_type(8)));
typedef int v4i __attribute__((ext_vector_type(4)));
typedef int v8i __attribute__((ext_vector_type(8)));
typedef short s16x16 __attribute__((ext_vector_type(16)));
typedef short bf16x4 __attribute__((ext_vector_type(4)));
typedef __bf16 bf16x2_t __attribute__((ext_vector_type(2)));
typedef GAS unsigned gu32;
#define RLX_AGENT __ATOMIC_RELAXED, __HIP_MEMORY_SCOPE_AGENT
#define LDS_WAIT() asm volatile("s_waitcnt lgkmcnt(0)" ::: "memory")
#define VM_WAIT() asm volatile("s_waitcnt vmcnt(0)" ::: "memory")
#define DI __device__ __forceinline__

DI unsigned cvtpk(float lo, float hi) { f32x2 v = {lo, hi}; bf16x2_t b = __builtin_convertvector(v, bf16x2_t); return __builtin_bit_cast(unsigned, b); }
DI float bflo(unsigned w) { return __builtin_bit_cast(float, w << 16); }
DI float bfhi(unsigned w) { return __builtin_bit_cast(float, w & 0xffff0000u); }
DI float bf2f(bf16 b) { return __builtin_bit_cast(float, ((unsigned)b) << 16); }
DI bf16 f2bf(float f) { return (bf16)(cvtpk(f, 0.f) & 0xffffu); }
DI unsigned pk4_fp8(float a, float b, float c, float d) { int w = 0; w = __builtin_amdgcn_cvt_pk_fp8_f32(a, b, w, false); w = __builtin_amdgcn_cvt_pk_fp8_f32(c, d, w, true); return (unsigned)w; }
DI float sigmoidf_(float x) { return __builtin_amdgcn_rcpf(1.f + __expf(-x)); }
DI float xor32f(float v) { const unsigned u = __builtin_bit_cast(unsigned, v); const auto r = __builtin_amdgcn_permlane32_swap(u, u, false, false);
    return __builtin_bit_cast(float, (__lane_id() & 32u) ? (unsigned)r[0] : (unsigned)r[1]); }
DI float wave_sum(float v) {
#pragma unroll
    for (int o = 1; o < 64; o <<= 1) v += __shfl_xor(v, o);
    return v;
}
DI float wave_max(float v) {
#pragma unroll
    for (int o = 1; o < 64; o <<= 1) v = fmaxf(v, __shfl_xor(v, o));
    return v;
}
DI int crow(int reg, int h) { return (reg & 3) + 8 * (reg >> 2) + 4 * h; }
#define MFMA32(a, b, c) __builtin_amdgcn_mfma_f32_32x32x16_bf16((a), (b), (c), 0, 0, 0)

constexpr int M = 16384, D = 2048;
constexpr int INC = 6152;
constexpr int NE = 32, DFF = 2048, TOPK = 4;
constexpr int NCH = 256, CH = 64;
constexpr float EPS = 1e-5f;
constexpr size_t VT_B = (size_t)4 * 256 * 256 * 64;
constexpr int ACT_ROWS = 65536 + 32 * 256;
constexpr float YM_SCALE = 16.f, YM_INV = 1.f / 16.f;

namespace pg8 {
#define PG8_LAS __attribute__((address_space(3)))
typedef unsigned short bf16_t;
typedef unsigned u32x4 __attribute__((ext_vector_type(4)));
constexpr int BM = 256, BK = 64, HALF = 128, HTB = HALF * BK * 2, STAGE_BYTES = 8 * HTB, NXCD = 8, WGM = 4;
__host__ __device__ __forceinline__ int lds_byte(int r, int c) { const int st = (r >> 4) * 2 + (c >> 5), rr = r & 15, cc = c & 31, ob = rr * 64 + cc * 2; return st * 1024 + (ob ^ (((ob >> 9) & 1) << 5)); }
__host__ __device__ __forceinline__ void stage_rc(int b, int& R, int& C) { const int st = b / 1024, sb = b % 1024, swz = sb ^ (((sb >> 9) & 1) << 5); R = (st >> 1) * 16 + swz / 64; C = (st & 1) * 32 + (swz % 64) / 2; }
__host__ __device__ __forceinline__ int perm32(int rho) { const int n = rho >> 4, i = rho & 15; return 8 * (i >> 2) + 4 * n + (i & 3); }

struct Unit { int pm, pn, ui; };
struct Gemm { const bf16_t* A; const bf16_t* Bt; int M, N, K; };

struct StaticOrder {
    int nM, nN, nwg, G, c;
    __device__ void init(int M_, int N_, int G_, int c_) { nM = M_ / BM; nN = N_ / BM; nwg = nM * nN; G = G_; c = c_; }
    __device__ bool next(int i, Unit& u) const {
        const long L = (long)i * G + c; if (L >= nwg) return false;
        int wgid = (int)L; { const int q = nwg / NXCD, r = nwg % NXCD, xcd = wgid % NXCD, off = wgid / NXCD; wgid = (xcd < r ? xcd * (q + 1) : r * (q + 1) + (xcd - r) * q) + off; }
        const int nig = WGM * nN, gid = wgid / nig, fm = gid * WGM, gsz = (nM - fm) < WGM ? (nM - fm) : WGM;
        u.pm = __builtin_amdgcn_readfirstlane(fm + ((wgid % nig) % gsz)); u.pn = __builtin_amdgcn_readfirstlane((wgid % nig) / gsz); u.ui = i; return true;
    }
    unsigned rowbytes;
    __device__ __forceinline__ unsigned tok(int i, int r) const { Unit u; (void)next(i, u); return (unsigned)(u.pm * BM + r) * rowbytes; }
};
struct MoeOrder {
    const PG8_LAS int* tab; const PG8_LAS unsigned short* tok16; int n; unsigned rowbytes; int maxu;
    __device__ __forceinline__ bool next(int i, Unit& u) const { if (i >= n) return false; u.pm = __builtin_amdgcn_readfirstlane(tab[2 * i]); u.pn = __builtin_amdgcn_readfirstlane(tab[2 * i + 1]); u.ui = i; return true; }
    __device__ __forceinline__ unsigned tok(int i, int r) const { return ((unsigned)tab[3 * maxu + i] + (unsigned)tok16[i * 256 + r]) * rowbytes; }
};

__device__ __forceinline__ f32x4 mma8(const bf16x8& b0, const bf16x8& b1, const bf16x8& a0, const bf16x8& a1, const f32x4& c) {
    const v8i b = __builtin_shufflevector(__builtin_bit_cast(v4i, b0), __builtin_bit_cast(v4i, b1), 0, 1, 2, 3, 4, 5, 6, 7), a = __builtin_shufflevector(__builtin_bit_cast(v4i, a0), __builtin_bit_cast(v4i, a1), 0, 1, 2, 3, 4, 5, 6, 7);
    return __builtin_amdgcn_mfma_scale_f32_16x16x128_f8f6f4(b, a, c, 0, 0, 0, 0x79797979, 0, 0x7f7f7f7f); }
template <class Epi, class Sched, bool ALIGN_EPI, bool GATHER, bool FP8 = false>
__device__ __forceinline__ void gemm_phase(PG8_LAS unsigned char* lds, const Gemm g, const Sched& S, const Epi& E) {
    const int tid = threadIdx.x, wid = __builtin_amdgcn_readfirstlane(tid >> 6), lane = tid & 63, wr = wid >> 2, wc = wid & 3, fr = lane & 15, fq = lane >> 4;
    const int K = g.K, nt = K / BK;
    unsigned voffA[2], voffB[2]; int rowA[2]; unsigned colA[2];
#pragma unroll
    for (int i = 0; i < 2; ++i) { int R, C; stage_rc(tid * 16 + i * 8192, R, C); const int Rb = Epi::PERM ? ((R & ~31) + perm32(R & 31)) : R;
        voffA[i] = (unsigned)(R * K + C) * 2u; voffB[i] = (unsigned)(Rb * K + C) * 2u; rowA[i] = R; colA[i] = (unsigned)C * 2u; }
    const unsigned kstep = (unsigned)(BK * 2);
    const unsigned hstep = (unsigned)HALF * K * 2;
    const unsigned tstep = 2 * hstep;
    const unsigned ldsw = (unsigned)wid * 1024u;
    const int aoff = lds_byte(wr * 64 + fr, fq * 8), boff = lds_byte(wc * 32 + fr, fq * 8);
    constexpr int KSTR = 1024;
#define PG8_SA(b, h) (((b) * 2 + (h)) * HTB)
#define PG8_SB(b, h) ((4 + (b) * 2 + (h)) * HTB)
    const __amdgpu_buffer_rsrc_t rsA = __builtin_amdgcn_make_buffer_rsrc((void*)g.A, 0, 0xffffffffu, 0x00020000), rsB = __builtin_amdgcn_make_buffer_rsrc((void*)g.Bt, 0, 0xffffffffu, 0x00020000);
#define PG8_STAGE(bufoff, soff, voff) do { _Pragma("unroll") for (int _i = 0; _i < 2; ++_i) \
        __builtin_amdgcn_raw_ptr_buffer_load_lds(rsB, (PG8_LAS unsigned*)(lds + (bufoff) + ldsw + _i * 8192), 16, (int)(voff)[_i], (int)(soff), 0, 0); } while (0)
#define PG8_STAGE_A(bufoff, ubase, V, kb, h) do { _Pragma("unroll") for (int _i = 0; _i < 2; ++_i) { \
        if constexpr (GATHER) __builtin_amdgcn_raw_ptr_buffer_load_lds(rsA, (PG8_LAS unsigned*)(lds + (bufoff) + ldsw + _i * 8192), 16, (int)(V)[h][_i], (int)(kb), 0, 0); \
        else __builtin_amdgcn_raw_ptr_buffer_load_lds(rsA, (PG8_LAS unsigned*)(lds + (bufoff) + ldsw + _i * 8192), 16, (int)voffA[_i], (int)((ubase) + (kb) + (unsigned)(h) * hstep), 0, 0); } } while (0)
#define PG8_LDA(dst, b, h) do { _Pragma("unroll") for (int m = 0; m < 4; ++m) _Pragma("unroll") for (int k = 0; k < 2; ++k) dst[m][k] = *(const PG8_LAS bf16x8*)(lds + PG8_SA(b, h) + aoff + m * 2048 + k * KSTR); } while (0)
#define PG8_LDB(dst, b, h) do { _Pragma("unroll") for (int n = 0; n < 2; ++n) _Pragma("unroll") for (int k = 0; k < 2; ++k) dst[n][k] = *(const PG8_LAS bf16x8*)(lds + PG8_SB(b, h) + boff + n * 2048 + k * KSTR); } while (0)
#define PG8_MMA(ai, bj, At, Bt) do { __builtin_amdgcn_s_setprio(1); _Pragma("unroll") for (int m = 0; m < 4; ++m) _Pragma("unroll") for (int n = 0; n < 2; ++n) { \
        if constexpr (FP8) acc[ai][bj][m][n] = mma8(Bt[n][0], Bt[n][1], At[m][0], At[m][1], acc[ai][bj][m][n]); \
        else { _Pragma("unroll") for (int k = 0; k < 2; ++k) acc[ai][bj][m][n] = __builtin_amdgcn_mfma_f32_16x16x32_bf16(Bt[n][k], At[m][k], acc[ai][bj][m][n], 0, 0, 0); } } __builtin_amdgcn_s_setprio(0); } while (0)
#define PG8_WAIT_V(n) asm volatile("s_waitcnt vmcnt(" #n ")" ::: "memory")
#define PG8_WAIT_L(n) asm volatile("s_waitcnt lgkmcnt(" #n ")" ::: "memory")
#define PG8_BAR __builtin_amdgcn_s_barrier()
#define PG8_SCHED __builtin_amdgcn_sched_barrier(0)
    Unit cur, nxt; int ui = 0;
    if (!S.next(0, cur)) return;
    f32x4 acc[2][2][4][2];
#pragma unroll
    for (int a = 0; a < 2; ++a)
#pragma unroll
        for (int b = 0; b < 2; ++b)
#pragma unroll
            for (int m = 0; m < 4; ++m)
#pragma unroll
                for (int n = 0; n < 2; ++n) acc[a][b][m][n] = (f32x4){0.f, 0.f, 0.f, 0.f};
    bf16x8 At[4][2], B0[2][2], B1[2][2];
    unsigned vg[2][2] = {{0u, 0u}, {0u, 0u}};
    if constexpr (GATHER) {
#pragma unroll
        for (int h = 0; h < 2; ++h)
#pragma unroll
            for (int i = 0; i < 2; ++i) vg[h][i] = S.tok(0, h * HALF + rowA[i]) + colA[i];
    }
    unsigned cA = GATHER ? 0u : (unsigned)cur.pm * tstep, cB = (unsigned)cur.pn * tstep;
    PG8_STAGE(PG8_SB(0, 0), cB, voffB); PG8_STAGE(PG8_SB(0, 1), cB + hstep, voffB); PG8_STAGE_A(PG8_SA(0, 0), cA, vg, 0u, 0); PG8_STAGE_A(PG8_SA(0, 1), cA, vg, 0u, 1);
    if (wr == 1) PG8_BAR;
    PG8_WAIT_V(2); PG8_BAR;
    PG8_STAGE(PG8_SB(1, 0), cB + kstep, voffB); PG8_STAGE_A(PG8_SA(1, 0), cA, vg, kstep, 0); PG8_STAGE(PG8_SB(1, 1), cB + hstep + kstep, voffB);
    PG8_WAIT_V(6); PG8_BAR;
    for (;;) {
        const bool has_next = S.next(ui + 1, nxt);
        const unsigned nA = GATHER ? 0u : (has_next ? (unsigned)nxt.pm * tstep : cA), nB = has_next ? (unsigned)nxt.pn * tstep : cB;
        for (int t = 0; t < nt; t += 2) {
            const bool last = (t == nt - 2);
            const unsigned k1 = (unsigned)(t + 1) * kstep;
            const unsigned a2b = last ? nA : cA; const unsigned k2 = last ? 0u : (unsigned)(t + 2) * kstep, k3 = k2 + kstep;
            const unsigned b2 = last ? nB : cB + (unsigned)(t + 2) * kstep; const unsigned b3 = b2 + kstep;
            PG8_LDB(B0, 0, 0); PG8_LDB(B1, 0, 1); PG8_SCHED; PG8_LDA(At, 0, 0); PG8_STAGE_A(PG8_SA(1, 1), cA, vg, k1, 1);
            if constexpr (GATHER) { if (last && has_next) {
#pragma unroll
                for (int h = 0; h < 2; ++h)
#pragma unroll
                    for (int i = 0; i < 2; ++i) vg[h][i] = S.tok(ui + 1, h * HALF + rowA[i]) + colA[i]; } }
            PG8_WAIT_V(8); PG8_WAIT_L(0); PG8_BAR; PG8_MMA(0, 0, At, B0); PG8_MMA(0, 1, At, B1); PG8_BAR; PG8_SCHED;
            PG8_LDA(At, 0, 1); PG8_STAGE(PG8_SB(0, 0), b2, voffB); PG8_STAGE(PG8_SB(0, 1), b2 + hstep, voffB); PG8_STAGE_A(PG8_SA(0, 0), a2b, vg, k2, 0);
            PG8_WAIT_V(8); PG8_WAIT_L(0); PG8_BAR; PG8_MMA(1, 0, At, B0); PG8_MMA(1, 1, At, B1); PG8_BAR; PG8_SCHED;
            PG8_LDB(B0, 1, 0); PG8_LDB(B1, 1, 1); PG8_SCHED; PG8_LDA(At, 1, 0); PG8_STAGE_A(PG8_SA(0, 1), a2b, vg, k2, 1);
            PG8_WAIT_V(8); PG8_WAIT_L(0); PG8_BAR; PG8_MMA(0, 0, At, B0); PG8_MMA(0, 1, At, B1); PG8_BAR; PG8_SCHED;
            PG8_LDA(At, 1, 1); PG8_STAGE(PG8_SB(1, 0), b3, voffB); PG8_STAGE(PG8_SB(1, 1), b3 + hstep, voffB); PG8_STAGE_A(PG8_SA(1, 0), a2b, vg, k3, 0);
            PG8_WAIT_V(8); PG8_WAIT_L(0); PG8_BAR; PG8_MMA(1, 0, At, B0); PG8_MMA(1, 1, At, B1); PG8_BAR; PG8_SCHED;
        }
        if constexpr (ALIGN_EPI) { if (wr == 0) PG8_BAR; }
        E(acc, cur, wr, wc, fr, fq);
        if (!has_next) break;
#pragma unroll
        for (int a = 0; a < 2; ++a)
#pragma unroll
            for (int b = 0; b < 2; ++b)
#pragma unroll
                for (int m = 0; m < 4; ++m)
#pragma unroll
                    for (int n = 0; n < 2; ++n) acc[a][b][m][n] = (f32x4){0.f, 0.f, 0.f, 0.f};
        cur = nxt; cA = nA; cB = nB; ++ui;
        if constexpr (ALIGN_EPI) { if (wr == 1) PG8_BAR; }
    }
    PG8_WAIT_V(0);
    if constexpr (!ALIGN_EPI) { if (wr == 0) PG8_BAR; }
    PG8_BAR;
#undef PG8_SA
#undef PG8_SB
#undef PG8_STAGE
#undef PG8_STAGE_A
#undef PG8_LDA
#undef PG8_LDB
#undef PG8_MMA
#undef PG8_WAIT_V
#undef PG8_WAIT_L
#undef PG8_BAR
#undef PG8_SCHED
}

#define EPI_ROWS(...) _Pragma("unroll") for (int ai = 0; ai < 2; ++ai) _Pragma("unroll") for (int m = 0; m < 4; ++m) { const int row = u.pm * BM + wr * 64 + fr + ai * HALF + m * 16; \
        _Pragma("unroll") for (int bj = 0; bj < 2; ++bj) { __VA_ARGS__ } }
DI u32x4 pack8(const f32x4& v0, const f32x4& v1) { u32x4 w; w.x = cvtpk(v0[0], v0[1]); w.y = cvtpk(v0[2], v0[3]); w.z = cvtpk(v1[0], v1[1]); w.w = cvtpk(v1[2], v1[3]); return w; }
DI void unpack8(const u32x4& w, f32x4& v0, f32x4& v1) { v0 = (f32x4){bflo(w.x), bfhi(w.x), bflo(w.y), bfhi(w.y)}; v1 = (f32x4){bflo(w.z), bfhi(w.z), bflo(w.w), bfhi(w.w)}; }

struct EpiPlain { static constexpr bool PERM = true; bf16_t* O; int ldc;
    __device__ __forceinline__ void operator()(const f32x4 (&acc)[2][2][4][2], const Unit& u, int wr, int wc, int fr, int fq) const {
        const int col0 = u.pn * BM + wc * 32 + 8 * fq;
        EPI_ROWS( *(u32x4*)(O + (size_t)row * ldc + col0 + bj * HALF) = pack8(acc[ai][bj][m][0], acc[ai][bj][m][1]); )
    } };
struct EpiVT { static constexpr bool PERM = true; bf16_t* VT;
    __device__ __forceinline__ void operator()(const f32x4 (&acc)[2][2][4][2], const Unit& u, int wr, int wc, int fr, int fq) const {
        const int col0 = u.pn * BM + wc * 32 + 8 * fq;
        if (u.pm < 4) {
            EPI_ROWS( const int col = col0 + bj * HALF, hd = row >> 8, v = row & 255;
                *(u32x4*)(VT + ((((size_t)(hd * 256 + (col >> 6)) * 256 + v) << 6) + (col & 63))) = pack8(acc[ai][bj][m][0], acc[ai][bj][m][1]); )
        } else {
            EPI_ROWS( const int col = col0 + bj * HALF, r2 = row - 1024, hd = r2 >> 7, d = r2 & 127;
                *(u32x4*)(VT + VT_B + ((((size_t)(hd * 512 + (col >> 5)) * 128 + d) << 5) + (col & 31))) = pack8(acc[ai][bj][m][0], acc[ai][bj][m][1]); )
        }
    } };
struct EpiGate { static constexpr bool PERM = true; bf16_t* GT; const float* bmg;
    __device__ __forceinline__ void operator()(const f32x4 (&acc)[2][2][4][2], const Unit& u, int wr, int wc, int fr, int fq) const {
        const int col0 = u.pn * BM + wc * 32 + 8 * fq, tl8 = (((wr * 4 + wc) * 64) + fq * 16 + fr) * 8;
        f32x4 bv[2][2];
#pragma unroll
        for (int bj = 0; bj < 2; ++bj)
#pragma unroll
            for (int n = 0; n < 2; ++n) bv[bj][n] = *(const f32x4*)(bmg + col0 + bj * HALF + 4 * n);
        EPI_ROWS( f32x4 v0 = (acc[ai][bj][m][0] + bv[bj][0]) * -1.4426950408889634f, v1 = (acc[ai][bj][m][1] + bv[bj][1]) * -1.4426950408889634f;
            _Pragma("unroll") for (int q = 0; q < 4; ++q) { v0[q] = __builtin_amdgcn_exp2f(v0[q]); v1[q] = __builtin_amdgcn_exp2f(v1[q]); }
            v0 = v0 + 1.0f; v1 = v1 + 1.0f;
            _Pragma("unroll") for (int q = 0; q < 4; ++q) { v0[q] = __builtin_amdgcn_rcpf(v0[q]); v1[q] = __builtin_amdgcn_rcpf(v1[q]); }
            *(u32x4*)(GT + (size_t)(u.pm * 16 + u.pn) * 65536 + ((ai * 4 + m) * 2 + bj) * 4096 + tl8) = pack8(v0, v1); )
    } };
template <bool ADD> struct EpiMix { static constexpr bool PERM = true; bf16_t* MIX; bf16_t* MIXA; const bf16_t* GT; int gt0;
    __device__ __forceinline__ void operator()(const f32x4 (&acc)[2][2][4][2], const Unit& u, int wr, int wc, int fr, int fq) const {
        const int col0 = u.pn * BM + wc * 32 + 8 * fq, tl8 = (((wr * 4 + wc) * 64) + fq * 16 + fr) * 8;
        const bf16_t* gt = GT + (size_t)(u.pm * 16 + u.pn + gt0) * 65536 + tl8; bf16_t* ma = MIXA + (size_t)(u.pm * 8 + u.pn) * 65536 + tl8;
        if constexpr (!ADD) {
            u32x4 gw[2][4][2];
#pragma unroll
            for (int ai = 0; ai < 2; ++ai)
#pragma unroll
                for (int m = 0; m < 4; ++m)
#pragma unroll
                    for (int bj = 0; bj < 2; ++bj) gw[ai][m][bj] = *(const u32x4*)(gt + ((ai * 4 + m) * 2 + bj) * 4096);
            EPI_ROWS( const int go = ((ai * 4 + m) * 2 + bj) * 4096; f32x4 g0, g1; unpack8(gw[ai][m][bj], g0, g1);
                *(u32x4*)(ma + go) = pack8(acc[ai][bj][m][0] * g0, acc[ai][bj][m][1] * g1); )
        } else {
#pragma unroll
            for (int ai = 0; ai < 2; ++ai) {
                u32x4 gw[4][2], pw[4][2];
#pragma unroll
                for (int m = 0; m < 4; ++m)
#pragma unroll
                    for (int bj = 0; bj < 2; ++bj) { const int go = ((ai * 4 + m) * 2 + bj) * 4096; gw[m][bj] = *(const u32x4*)(gt + go); pw[m][bj] = *(const u32x4*)(ma + go); }
#pragma unroll
                for (int m = 0; m < 4; ++m) { const int row = u.pm * BM + wr * 64 + fr + ai * HALF + m * 16;
#pragma unroll
                    for (int bj = 0; bj < 2; ++bj) { f32x4 g0, g1, p0, p1; unpack8(gw[m][bj], g0, g1); unpack8(pw[m][bj], p0, p1);
                        *(u32x4*)(MIX + (size_t)row * D + col0 + bj * HALF) = pack8(acc[ai][bj][m][0] * g0 + p0, acc[ai][bj][m][1] * g1 + p1); } }
            }
        }
    } };
struct EpiX2 { static constexpr bool PERM = true; const float* X; bf16_t* X2;
    __device__ __forceinline__ void operator()(const f32x4 (&acc)[2][2][4][2], const Unit& u, int wr, int wc, int fr, int fq) const {
        const int col0 = u.pn * BM + wc * 32 + 8 * fq;
#pragma unroll
        for (int ai = 0; ai < 2; ++ai) {
            f32x4 xv[4][2][2];
#pragma unroll
            for (int m = 0; m < 4; ++m)
#pragma unroll
                for (int bj = 0; bj < 2; ++bj) { const size_t o = (size_t)(u.pm * BM + wr * 64 + fr + ai * HALF + m * 16) * D + col0 + bj * HALF; xv[m][bj][0] = *(const f32x4*)(X + o); xv[m][bj][1] = *(const f32x4*)(X + o + 4); }
#pragma unroll
            for (int m = 0; m < 4; ++m)
#pragma unroll
                for (int bj = 0; bj < 2; ++bj) { const size_t o = (size_t)(u.pm * BM + wr * 64 + fr + ai * HALF + m * 16) * D + col0 + bj * HALF;
                    *(u32x4*)(X2 + o) = pack8(xv[m][bj][0] + acc[ai][bj][m][0], xv[m][bj][1] + acc[ai][bj][m][1]); }
        }
    } };
template <bool OUT8> struct EpiMoeUp { static constexpr bool PERM = true; bf16_t* ACT; const PG8_LAS float* bias;
    __device__ __forceinline__ void operator()(const f32x4 (&acc)[2][2][4][2], const Unit& u, int wr, int wc, int fr, int fq) const {
        const int pnl = u.pn & 15, j0 = pnl * 128 + wc * 32 + 8 * fq;
        f32x4 bg[2], bu[2];
#pragma unroll
        for (int n = 0; n < 2; ++n) { bg[n] = *(const PG8_LAS f32x4*)(bias + u.ui * 256 + wc * 32 + 8 * fq + 4 * n); bu[n] = *(const PG8_LAS f32x4*)(bias + u.ui * 256 + 128 + wc * 32 + 8 * fq + 4 * n); }
#pragma unroll
        for (int ai = 0; ai < 2; ++ai)
#pragma unroll
            for (int m = 0; m < 4; ++m) { const int row = u.pm * BM + wr * 64 + fr + ai * HALF + m * 16; f32x4 o[2];
#pragma unroll
                for (int n = 0; n < 2; ++n) { f32x4 gt = acc[ai][0][m][n] + bg[n], up = acc[ai][1][m][n] + bu[n];
#pragma unroll
                    for (int q = 0; q < 4; ++q) { gt[q] = fminf(gt[q], 7.f); up[q] = fminf(fmaxf(up[q], -7.f), 7.f); }
                    f32x4 e = gt * (-1.702f * 1.4426950408889634f);
#pragma unroll
                    for (int q = 0; q < 4; ++q) e[q] = __builtin_amdgcn_exp2f(e[q]);
                    e = e + 1.0f;
#pragma unroll
                    for (int q = 0; q < 4; ++q) e[q] = __builtin_amdgcn_rcpf(e[q]);
                    o[n] = (up + 1.0f) * gt * e; }
                if constexpr (OUT8) { v2u w; w.x = pk4_fp8(o[0][0], o[0][1], o[0][2], o[0][3]); w.y = pk4_fp8(o[1][0], o[1][1], o[1][2], o[1][3]); *(v2u*)((unsigned char*)ACT + (size_t)row * DFF + j0) = w; }
                else *(u32x4*)(ACT + (size_t)row * DFF + j0) = pack8(o[0], o[1]); }
    } };
struct EpiMoeDn { static constexpr bool PERM = true; unsigned char* YM; const PG8_LAS float* bias;
    __device__ __forceinline__ void operator()(const f32x4 (&acc)[2][2][4][2], const Unit& u, int wr, int wc, int fr, int fq) const {
        const int pnl = u.pn & 7, col0 = pnl * BM + wc * 32 + 8 * fq;
        f32x4 bv[2][2];
#pragma unroll
        for (int bj = 0; bj < 2; ++bj)
#pragma unroll
            for (int n = 0; n < 2; ++n) bv[bj][n] = *(const PG8_LAS f32x4*)(bias + u.ui * 256 + bj * HALF + wc * 32 + 8 * fq + 4 * n);
        EPI_ROWS( const f32x4 v0 = (acc[ai][bj][m][0] + bv[bj][0]) * YM_SCALE, v1 = (acc[ai][bj][m][1] + bv[bj][1]) * YM_SCALE;
            v2u w; w.x = pk4_fp8(v0[0], v0[1], v0[2], v0[3]); w.y = pk4_fp8(v1[0], v1[1], v1[2], v1[3]);
            *(v2u*)(YM + (size_t)row * D + col0 + bj * HALF) = w; )
    } };
}

constexpr int NWAVES = 8;
#ifndef MK_N_LAUNCHES
#define MK_N_LAUNCHES 1
#endif
constexpr int PER_PHASE = 11;
#ifndef FP8_UP
#define FP8_UP 1
#endif
#ifndef FP8_DN
#define FP8_DN 1
#endif
constexpr bool kFp8Up = FP8_UP, kFp8Dn = FP8_DN;
constexpr float W8_SCALE = 64.f, W8_INV = 1.f / 64.f;
#ifndef NCONV
#define NCONV 64
#endif
constexpr int NCONV_WG = NCONV;
constexpr int N_LAUNCHES = MK_N_LAUNCHES;

constexpr size_t MiB = 1u << 20;
constexpr size_t WS_CTL = 0, CTL_ZERO_BYTES = 1 * MiB;
constexpr size_t WS_W1N = 1 * MiB;
constexpr size_t WS_WMG8 = WS_W1N + 16 * MiB;
constexpr size_t WS_W1V = WS_W1N + 32 * MiB;
constexpr size_t WS_WPA = WS_W1V + 8 * MiB;
constexpr size_t WS_WPB = WS_WPA + 4 * MiB;
constexpr size_t WS_WOT = WS_WPB + 4 * MiB;
constexpr size_t WS_WRH = WS_WOT + 8 * MiB;
constexpr size_t WS_WRL = WS_WRH + 128 * 1024;
constexpr size_t WS_WGU = WS_WRH + 1 * MiB;
constexpr size_t WS_WDN = WS_WGU + 512 * MiB;
constexpr size_t WS_H = WS_WDN + 256 * MiB;
constexpr size_t WS_AIF = WS_H + 64 * MiB;
constexpr size_t WS_QKO = WS_AIF + 1 * MiB;
constexpr size_t WS_GT = WS_QKO + 128 * MiB;
constexpr size_t WS_VT = WS_GT + 128 * MiB;
constexpr size_t WS_QC = WS_VT + 64 * MiB;
constexpr size_t WS_KC = WS_QC + 16 * MiB;
constexpr size_t WS_SC = WS_KC + 16 * MiB;
constexpr size_t SC_G = 4 * (size_t)M * 4, SC_MLOC = SC_G + 4096, SC_MPREV = SC_MLOC + 4096;
constexpr size_t WS_CLOC = WS_SC + 1 * MiB;
constexpr size_t WS_NLOC = WS_CLOC + 128 * MiB;
constexpr size_t WS_CPREV = WS_NLOC + 1 * MiB;
constexpr size_t WS_NPREV = WS_CPREV + 64 * MiB;
constexpr size_t WS_YA = WS_NPREV + 1 * MiB;
constexpr size_t WS_YB = WS_YA + 32 * MiB;
constexpr size_t WS_MIX = WS_YB + 32 * MiB;
constexpr size_t WS_X2 = WS_MIX + 64 * MiB;
constexpr size_t WS_H2 = WS_X2 + 128 * MiB;
constexpr size_t WS_H8 = WS_H2;
constexpr size_t WS_PE = WS_H2 + 64 * MiB;
constexpr size_t WS_PG = WS_PE + 256 * 1024;
constexpr size_t WS_LIST = WS_PG + 256 * 1024;
constexpr size_t WS_ACT = WS_LIST + 2 * MiB + 512 * 1024;
constexpr size_t WS_YM = WS_ACT + 288 * MiB;
constexpr size_t WS_END = WS_YM + 288 * MiB;
constexpr int CW_BAR = 4096;
constexpr int CW_Q = 12288;
constexpr int CW_CNT = 16384;

constexpr int RING_OFF = 0, RING_BYTES = 131072;
constexpr int TOK_OFF = RING_BYTES, MAX_UNITS = 18, TOK_BYTES = MAX_UNITS * 512;
constexpr int BIAS_OFF = TOK_OFF + TOK_BYTES, BIAS_BYTES = MAX_UNITS * 1024;
constexpr int UTAB_OFF = BIAS_OFF + BIAS_BYTES;
constexpr int TST_OFF = UTAB_OFF + 512;
constexpr int MISC_OFF = TST_OFF + 512;
constexpr int LDS_BYTES = MISC_OFF + 128;
static_assert(LDS_BYTES <= 163840, "LDS");

#define XB_TMO      128
#define XB_XCNT(j)  (256  + 64 * (j))
#define XB_XSUB(j)  (1280 + 64 * (j))
#define XB_XGEN(j)  (2304 + 64 * (j))
#define XB_TOP      3328
#define XB_TOPGEN   3392
#define XCD_BAR_WORDS 3456
#define XB_SPIN_CAP (1u << 22)
DI unsigned xb_ld(unsigned* p)              { return __hip_atomic_load(p, __ATOMIC_RELAXED, __HIP_MEMORY_SCOPE_AGENT); }
DI unsigned xb_add(unsigned* p, unsigned v) { return __hip_atomic_fetch_add(p, v, __ATOMIC_RELAXED, __HIP_MEMORY_SCOPE_AGENT); }
DI unsigned xb_xcc_id() { return (unsigned)__builtin_amdgcn_s_getreg((3 << 11) | 20) & 0xFu; }
#define XB_SPIN(cond, bar) do { unsigned _sp = 0; while (cond) { __builtin_amdgcn_s_sleep(1); \
    if ((++_sp & 255u) == 0u) { if (xb_ld(&(bar)[XB_TMO])) break; if (_sp > XB_SPIN_CAP) { atomicAdd(&(bar)[XB_TMO], 1u); break; } } } } while (0)
struct XcdBarrier { unsigned* bar; unsigned x; volatile LAS unsigned* st; };
DI XcdBarrier xcd_barrier_post(unsigned* bar, volatile LAS unsigned* st) {
    XcdBarrier b; b.bar = bar; b.x = xb_xcc_id(); b.st = st;
    if (threadIdx.x == 0) (void)xb_add(&bar[XB_XCNT(b.x)], 1u);
    return b;
}
DI void xcd_barrier_complete(unsigned* bar, unsigned x, unsigned& nloc, unsigned& nx) {
    const unsigned G = gridDim.x * gridDim.y * gridDim.z;
    unsigned sum, cnt, mine, sp = 0u;
    for (;;) {
        sum = 0u; cnt = 0u; mine = 0u;
#pragma unroll
        for (unsigned j = 0; j < 16; ++j) { const unsigned c = xb_ld(&bar[XB_XCNT(j)]); sum += c; cnt += (c > 0u) ? 1u : 0u; mine = (j == x) ? c : mine; }
        if (sum == G) break;
        __builtin_amdgcn_s_sleep(1);
        if ((++sp & 255u) == 0u) { if (xb_ld(&bar[XB_TMO])) break; if (sp > XB_SPIN_CAP) { atomicAdd(&bar[XB_TMO], 1u); break; } }
    }
    nloc = mine > 0u ? mine : 1u; nx = cnt > 0u ? cnt : 1u;
}
DI void xcd_barrier(const XcdBarrier& b) {
    asm volatile("s_waitcnt vmcnt(0)" ::: "memory");
    __syncthreads();
    if (threadIdx.x == 0) {
        unsigned* bar = b.bar;
        __builtin_amdgcn_s_waitcnt(0);
        unsigned nloc = b.st[0], nx = b.st[1];
        if (nloc == 0u) { xcd_barrier_complete(bar, b.x, nloc, nx); b.st[0] = nloc; b.st[1] = nx; }
        const unsigned old = xb_add(&bar[XB_XSUB(b.x)], 1u);
        const unsigned gen = old / nloc;
        if (old + 1u == (gen + 1u) * nloc) {
            __builtin_amdgcn_fence(__ATOMIC_RELEASE, "agent");
            asm volatile("s_waitcnt vmcnt(0)" ::: "memory");
            const unsigned og = xb_add(&bar[XB_TOP], 1u);
            const unsigned tg = og / nx;
            if (og + 1u == (tg + 1u) * nx) xb_add(&bar[XB_TOPGEN], 1u);
            else XB_SPIN(xb_ld(&bar[XB_TOPGEN]) == tg, bar);
            __builtin_amdgcn_fence(__ATOMIC_ACQUIRE, "agent");
            xb_add(&bar[XB_XGEN(b.x)], 1u);
            asm volatile("s_waitcnt vmcnt(0)" ::: "memory");
        } else {
            XB_SPIN(xb_ld(&bar[XB_XGEN(b.x)]) == gen, bar);
            __builtin_amdgcn_fence(__ATOMIC_ACQUIRE, "agent");
            asm volatile("s_waitcnt vmcnt(0)" ::: "memory");
        }
    }
    __syncthreads();
}

struct Frame {
    LAS unsigned char* lds;
    unsigned char* ws;
    gu32* ctl;
    int tid, lane, wave, G, bx;
    const float *x, *norm_mix, *w_in, *conv_w, *conv_b, *b_if, *norm_head, *w_pa, *w_pb, *w_mg, *b_mg, *w_out, *norm_ffn, *w_r, *b_r, *w_gu, *b_gu, *w_dn, *b_dn, *norm_final;
    float* out;
};
#define WSP(T, off) ((T*)(F.ws + (off)))

template <bool F8> DI void tr_item(const float* W, size_t pitch, size_t col0, int k0, void* WT, size_t drow0, int Kd, LAS unsigned char* scr, int lane) {
    constexpr int RB = F8 ? 128 : 256, PB = RB + 16;
    const int n4 = lane & 7, kr = lane >> 3;
    f32x4 v[16];
#pragma unroll
    for (int i = 0; i < 16; ++i) v[i] = __builtin_nontemporal_load((const GAS f32x4*)(W + (size_t)(k0 + 16 * kr + i) * pitch + col0 + 4 * n4));
#pragma unroll
    for (int q = 0; q < 4; ++q) { LAS unsigned char* rowp = scr + (q * 8 + n4) * PB + kr * (F8 ? 16 : 32);
        if constexpr (F8) { v4u o; o.x = pk4_fp8(v[0][q] * W8_SCALE, v[1][q] * W8_SCALE, v[2][q] * W8_SCALE, v[3][q] * W8_SCALE); o.y = pk4_fp8(v[4][q] * W8_SCALE, v[5][q] * W8_SCALE, v[6][q] * W8_SCALE, v[7][q] * W8_SCALE);
            o.z = pk4_fp8(v[8][q] * W8_SCALE, v[9][q] * W8_SCALE, v[10][q] * W8_SCALE, v[11][q] * W8_SCALE); o.w = pk4_fp8(v[12][q] * W8_SCALE, v[13][q] * W8_SCALE, v[14][q] * W8_SCALE, v[15][q] * W8_SCALE);
            *(LAS v4u*)rowp = o; }
        else { v4u o0, o1; o0.x = cvtpk(v[0][q], v[1][q]); o0.y = cvtpk(v[2][q], v[3][q]); o0.z = cvtpk(v[4][q], v[5][q]); o0.w = cvtpk(v[6][q], v[7][q]);
            o1.x = cvtpk(v[8][q], v[9][q]); o1.y = cvtpk(v[10][q], v[11][q]); o1.z = cvtpk(v[12][q], v[13][q]); o1.w = cvtpk(v[14][q], v[15][q]);
            *(LAS v4u*)rowp = o0; *(LAS v4u*)(rowp + 16) = o1; } }
    LDS_WAIT(); asm volatile("" ::: "memory");
    constexpr int CPR = RB / 16;
#pragma unroll
    for (int jj = 0; jj < (32 * CPR) / 64; ++jj) { const int idx = lane + 64 * jj, rho = idx / CPR, ch = idx % CPR, n = 4 * (rho & 7) + (rho >> 3);
        const v4u o = *(const LAS v4u*)(scr + rho * PB + 16 * ch);
        __builtin_nontemporal_store(o, (GAS v4u*)((unsigned char*)WT + ((drow0 + n) * (size_t)Kd + k0) * (F8 ? 1 : 2) + 16 * ch)); }
    LDS_WAIT(); asm volatile("" ::: "memory");
}
DI void p0_prologue(Frame& F) {
    LAS unsigned char* scr = F.lds + RING_OFF + F.wave * 8704;
    const int gw = F.bx * NWAVES + F.wave, NGW = F.G * NWAVES;
    bf16* W1N = WSP(bf16, WS_W1N); bf16* W1V = WSP(bf16, WS_W1V);
    constexpr int KB = D / 128;
    constexpr int I0 = KB * 32, I1 = KB * 32, I2 = KB * 64, I3 = KB * 128, I4 = KB * 32, I5 = KB * 32, I6 = 8 * 64, I7 = 8 * 64, I8 = KB * 64;
    constexpr int NSMALL = I0 + I1 + I2 + I3 + I4 + I5 + I6 + I7 + I8;
    for (int it = gw; it < NSMALL; it += NGW) {
        const float* W; size_t pitch, scol, drow; int ncols, K; bf16* WT; int r = it; bool f8 = false;
        if (r < I0) { W = F.w_in; pitch = INC; scol = 0; ncols = 1024; K = D; WT = W1N; drow = 0; }
        else if ((r -= I0) < I1) { W = F.w_in; pitch = INC; scol = 2048; ncols = 1024; K = D; WT = W1N; drow = 1024; }
        else if ((r -= I1) < I2) { W = F.w_in; pitch = INC; scol = 3080; ncols = 2048; K = D; WT = W1N; drow = 2048; }
        else if ((r -= I2) < I3) { f8 = true; W = F.w_mg; pitch = 4096; scol = 0; ncols = 4096; K = D; WT = WSP(bf16, WS_WMG8); drow = 0; }
        else if ((r -= I3) < I4) { W = F.w_in; pitch = INC; scol = 1024; ncols = 1024; K = D; WT = W1V; drow = 0; }
        else if ((r -= I4) < I5) { W = F.w_in; pitch = INC; scol = 5128; ncols = 1024; K = D; WT = W1V; drow = 1024; }
        else if ((r -= I5) < I6) { W = F.w_pa; pitch = D; scol = 0; ncols = 2048; K = 1024; WT = WSP(bf16, WS_WPA); drow = 0; }
        else if ((r -= I6) < I7) { W = F.w_pb; pitch = D; scol = 0; ncols = 2048; K = 1024; WT = WSP(bf16, WS_WPB); drow = 0; }
        else { r -= I7; W = F.w_out; pitch = D; scol = 0; ncols = 2048; K = D; WT = WSP(bf16, WS_WOT); drow = 0; }
        const int nbl = ncols / 32, kb = r / nbl, nb = r % nbl, n0 = 32 * nb;
        if (f8) tr_item<true>(W, pitch, scol + n0, 128 * kb, WT, drow + n0, K, scr, F.lane); else tr_item<false>(W, pitch, scol + n0, 128 * kb, WT, drow + n0, K, scr, F.lane);
    }
    for (int i = (F.bx * 512 + F.tid); i < NE * D; i += F.G * 512) { const int e = i / D, k = i % D; const float w = F.norm_ffn[k] * F.w_r[k * NE + e];
        const bf16 hi = f2bf(w); WSP(bf16, WS_WRH)[i] = hi; WSP(bf16, WS_WRL)[i] = f2bf(w - bf2f(hi)); }
    __syncthreads();
    LAS float* wif = (LAS float*)(F.lds + RING_OFF);
#pragma unroll
    for (int ii = 0; ii < 8 * D / 512; ++ii) { const int i = F.tid + 512 * ii, k = i >> 3, j = i & 7; wif[j * D + k] = F.w_in[(size_t)k * INC + 3072 + j]; }
    __syncthreads();
    bf16* H = WSP(bf16, WS_H); float* AIF = WSP(float, WS_AIF);
    f32x4 g[8], vn[8];
    { const GAS f32x4* gr = (const GAS f32x4*)F.norm_mix + F.lane;
#pragma unroll
      for (int j = 0; j < 8; ++j) g[j] = gr[64 * j];
      const GAS f32x4* xr = (const GAS f32x4*)(F.x + (size_t)(gw < M ? gw : 0) * D) + F.lane;
#pragma unroll
      for (int j = 0; j < 8; ++j) vn[j] = xr[64 * j]; }
    for (int m = gw; m < M; m += NGW) {
        f32x4 v[8]; float ss = 0.f;
#pragma unroll
        for (int j = 0; j < 8; ++j) { v[j] = vn[j]; ss += (v[j].x * v[j].x + v[j].y * v[j].y) + (v[j].z * v[j].z + v[j].w * v[j].w); }
        { const int mn = (m + NGW < M) ? m + NGW : m; const GAS f32x4* xr = (const GAS f32x4*)(F.x + (size_t)mn * D) + F.lane;
#pragma unroll
          for (int j = 0; j < 8; ++j) vn[j] = xr[64 * j]; }
        const float rstd = 1.f / sqrtf(wave_sum(ss) * (1.f / D) + EPS);
        GAS v2u* o8 = (GAS v2u*)(H + (size_t)m * D) + F.lane; GAS unsigned* o4 = (GAS unsigned*)(F.ws + WS_H8 + (size_t)m * D) + F.lane;
#pragma unroll
        for (int j = 0; j < 8; ++j) { v[j] = v[j] * rstd * g[j]; v2u w; w.x = cvtpk(v[j].x, v[j].y); w.y = cvtpk(v[j].z, v[j].w); o8[64 * j] = w; o4[64 * j] = pk4_fp8(v[j].x, v[j].y, v[j].z, v[j].w); }
        float p[8];
#pragma unroll
        for (int q = 0; q < 8; ++q) { float a = 0.f;
#pragma unroll
            for (int j = 0; j < 8; ++j) { const f32x4 w = *(const LAS f32x4*)(wif + q * D + 4 * F.lane + 256 * j); a += (v[j].x * w.x + v[j].y * w.y) + (v[j].z * w.z + v[j].w * w.w); }
            p[q] = a; asm volatile("" ::: "memory"); }
        const bool b5 = (F.lane & 32) != 0, b4 = (F.lane & 16) != 0, b3 = (F.lane & 8) != 0;
        float r4[4], r2[2], r1;
#pragma unroll
        for (int i = 0; i < 4; ++i) { const float snd = b5 ? p[i] : p[i + 4], kp = b5 ? p[i + 4] : p[i]; r4[i] = kp + __shfl_xor(snd, 32); }
#pragma unroll
        for (int i = 0; i < 2; ++i) { const float snd = b4 ? r4[i] : r4[i + 2], kp = b4 ? r4[i + 2] : r4[i]; r2[i] = kp + __shfl_xor(snd, 16); }
        { const float snd = b3 ? r2[0] : r2[1], kp = b3 ? r2[1] : r2[0]; r1 = kp + __shfl_xor(snd, 8); }
        r1 += __shfl_xor(r1, 4); r1 += __shfl_xor(r1, 2); r1 += __shfl_xor(r1, 1);
        { const int q = (F.lane >> 3) & 7; const int qq = ((q & 4) ? 4 : 0) + ((q & 2) ? 2 : 0) + (q & 1);
          if ((F.lane & 7) == 0) AIF[(size_t)m * 8 + qq] = r1 + F.b_if[qq]; }
    }
}

constexpr int CONV_BATCH = 8;
DI void conv_queue(Frame& F) {
    LAS unsigned char* scr = F.lds + RING_OFF + F.wave * 8704;
    constexpr int KB = D / 128, IGU = KB * 128, IDN = KB * 64, IEX = IGU + IDN, NITEMS = NE * IEX;
    for (;;) {
        int base = 0; if (F.lane == 0) base = (int)__hip_atomic_fetch_add((unsigned*)(F.ctl + CW_Q), (unsigned)CONV_BATCH, RLX_AGENT);
        base = __builtin_amdgcn_readfirstlane(base);
        if (base >= NITEMS) break;
        for (int it = base; it < base + CONV_BATCH && it < NITEMS; ++it) {
            const int e = it / IEX; int r = it % IEX;
            if (r < IGU) { const int kb = r / 128, nb = r % 128, n0 = 32 * nb, np = n0 & 2047; const size_t dr = (size_t)(np / 128) * 256 + (n0 >= 2048 ? 128 : 0) + (np % 128);
                if (kFp8Up) tr_item<true>(F.w_gu + (size_t)e * D * 4096, 4096, n0, 128 * kb, F.ws + WS_WGU + (size_t)e * 4096 * D, dr, D, scr, F.lane);
                else tr_item<false>(F.w_gu + (size_t)e * D * 4096, 4096, n0, 128 * kb, F.ws + WS_WGU + (size_t)e * 4096 * D * 2, dr, D, scr, F.lane); }
            else { r -= IGU; const int kb = r / 64, nb = r % 64, n0 = 32 * nb;
                if (kFp8Dn) tr_item<true>(F.w_dn + (size_t)e * DFF * D, D, n0, 128 * kb, F.ws + WS_WDN + (size_t)e * D * DFF, n0, DFF, scr, F.lane);
                else tr_item<false>(F.w_dn + (size_t)e * DFF * D, D, n0, 128 * kb, F.ws + WS_WDN + (size_t)e * D * DFF * 2, n0, DFF, scr, F.lane); }
        }
    }
}

struct AttnCtx { const bf16* ksrc; const bf16* vsrc; LAS unsigned char* vimg; LAS unsigned char* qimg; int n, h, vr_, vc_; float CS; };
template <bool DIAG> DI void attn_block(const AttnCtx& A, int kn, const bf16x8 (&akc)[8], bf16x8 (&akn)[8], v4u (&vreg)[8], f32x16 (&o)[4], float& carry) {
    const int n = A.n, h = A.h;
#pragma unroll
    for (int i = 0; i < 8; ++i) *(LAS v4u*)(A.vimg + (A.vr_ + 16 * i) * 80 + 16 * A.vc_) = vreg[i];
#pragma unroll
    for (int i = 0; i < 8; ++i) vreg[i] = *(const GAS v4u*)(A.vsrc + (size_t)kn * 4096 + 512 * i);
    { const bf16* krow = A.ksrc + (size_t)(32 * kn) * 4096;
#pragma unroll
      for (int s = 0; s < 8; ++s) akn[s] = *(const GAS bf16x8*)(krow + 16 * s); }
    __builtin_amdgcn_sched_barrier(0);
    f32x16 sc; bf16x8 bqs[8];
#pragma unroll
    for (int r = 0; r < 16; ++r) sc[r] = 0.f;
#pragma unroll
    for (int s = 0; s < 8; ++s) bqs[s] = *(const LAS bf16x8*)(A.qimg + n * 272 + 32 * s + 16 * h);
    __builtin_amdgcn_sched_barrier(0);
#pragma unroll
    for (int s = 0; s < 8; ++s) sc = MFMA32(akc[s], bqs[s], sc);
    float bt[16], kp[16];
#pragma unroll
    for (int r = 0; r < 16; ++r) { const float z = sc[r] * A.CS, e = __builtin_amdgcn_exp2f(-fabsf(z)), d = __builtin_amdgcn_rcpf(1.f + e), ed = e * d;
        float b_ = z >= 0.f ? d : ed, k_ = z >= 0.f ? ed : d;
        if (DIAG && !(crow(r, h) < n)) { b_ = 0.f; k_ = 1.f; }
        bt[r] = b_; kp[r] = k_; }
    float Gs[4], Go[4], T[4];
#pragma unroll
    for (int g = 0; g < 4; ++g) { Gs[g] = (kp[4 * g] * kp[4 * g + 1]) * (kp[4 * g + 2] * kp[4 * g + 3]); Go[g] = xor32f(Gs[g]); T[g] = Gs[g] * Go[g]; }
    float tail[4]; tail[3] = 1.f; tail[2] = T[3]; tail[1] = T[3] * T[2]; tail[0] = tail[1] * T[1];
    float att[16];
#pragma unroll
    for (int g = 0; g < 4; ++g) { float R = carry * tail[g] * (h == 0 ? Go[g] : 1.f);
#pragma unroll
        for (int i = 3; i >= 0; --i) { att[4 * g + i] = bt[4 * g + i] * R; R *= kp[4 * g + i]; } }
    carry *= tail[0] * T[0];
    bf16x4 vlo[4][2], vhi[4][2];
#pragma unroll
    for (int dt = 0; dt < 4; ++dt)
#pragma unroll
        for (int s = 0; s < 2; ++s) { const LAS unsigned char* vp = A.vimg + (32 * dt + n) * 80 + 32 * s + 8 * h;
            vlo[dt][s] = *(const LAS bf16x4*)vp; vhi[dt][s] = *(const LAS bf16x4*)(vp + 16); }
    __builtin_amdgcn_sched_barrier(0);
    bf16x8 pf[2];
#pragma unroll
    for (int s = 0; s < 2; ++s) { v4u w; w.x = cvtpk(att[8 * s], att[8 * s + 1]); w.y = cvtpk(att[8 * s + 2], att[8 * s + 3]); w.z = cvtpk(att[8 * s + 4], att[8 * s + 5]); w.w = cvtpk(att[8 * s + 6], att[8 * s + 7]);
        pf[s] = __builtin_bit_cast(bf16x8, w); }
#pragma unroll
    for (int dt = 0; dt < 4; ++dt)
#pragma unroll
        for (int s = 0; s < 2; ++s) { const bf16x8 av = __builtin_shufflevector(vlo[dt][s], vhi[dt][s], 0, 1, 2, 3, 4, 5, 6, 7);
            o[dt] = MFMA32(av, pf[s], o[dt]); }
}
DI void attn_wave_unit(const bf16* QKO, const bf16* VT, bf16* YB, int hd, int qt, int lane, LAS unsigned char* vimg) {
    const int n = lane & 31, h = lane >> 5, t0 = 32 * qt;
    AttnCtx A; A.n = n; A.h = h; A.vr_ = lane >> 2; A.vc_ = lane & 3; A.vimg = vimg; A.qimg = vimg + 10240;
    A.CS = 0.08838834764831845f * 1.4426950408889634f;
    A.vsrc = VT + VT_B + (size_t)hd * 512 * 4096 + A.vr_ * 32 + 8 * A.vc_;
    A.ksrc = QKO + (size_t)n * 4096 + 3072 + hd * 128 + 8 * h;
    { const bf16* qrow = QKO + (size_t)(t0 + n) * 4096 + 2048 + hd * 128 + 8 * h;
#pragma unroll
      for (int s = 0; s < 8; ++s) *(LAS bf16x8*)(A.qimg + n * 272 + 32 * s + 16 * h) = *(const GAS bf16x8*)(qrow + 16 * s); }
    f32x16 o[4];
#pragma unroll
    for (int d = 0; d < 4; ++d)
#pragma unroll
        for (int r = 0; r < 16; ++r) o[d][r] = 0.f;
    float carry = 1.f;
    bf16x8 akA[8], akB[8]; v4u vreg[8];
    { const bf16* krow = A.ksrc + (size_t)(32 * qt) * 4096;
#pragma unroll
      for (int s = 0; s < 8; ++s) akA[s] = *(const GAS bf16x8*)(krow + 16 * s);
#pragma unroll
      for (int i = 0; i < 8; ++i) vreg[i] = *(const GAS v4u*)(A.vsrc + (size_t)qt * 4096 + 512 * i); }
    int kb = qt;
    attn_block<true>(A, kb > 0 ? kb - 1 : 0, akA, akB, vreg, o, carry);
    while (kb > 0 && !__all(carry == 0.f)) {
        --kb; attn_block<false>(A, kb > 0 ? kb - 1 : 0, akB, akA, vreg, o, carry);
        if (kb == 0 || __all(carry == 0.f)) break;
        --kb; attn_block<false>(A, kb > 0 ? kb - 1 : 0, akA, akB, vreg, o, carry);
    }
    bf16* yrow = YB + (size_t)(t0 + n) * 1024 + hd * 128 + 4 * h;
#pragma unroll
    for (int dt = 0; dt < 4; ++dt)
#pragma unroll
        for (int g = 0; g < 4; ++g) { v2u w; w.x = cvtpk(o[dt][4 * g], o[dt][4 * g + 1]); w.y = cvtpk(o[dt][4 * g + 2], o[dt][4 * g + 3]); *(GAS v2u*)(yrow + 32 * dt + 8 * g) = w; }
}

DI void mlstm_a_unit(Frame& F, int hd, int c) {
    LAS float* sE = (LAS float*)(F.lds + RING_OFF);
    LAS float* sCW = (LAS float*)(F.lds + RING_OFF + 256);
    LAS bf16* sKeT = (LAS bf16*)(F.lds + RING_OFF + 8192);
    const int t0 = CH * c;
    const bf16* QKO = WSP(const bf16, WS_QKO); const float* AIF = WSP(const float, WS_AIF); const bf16* VT = WSP(const bf16, WS_VT);
    float* ACUM = WSP(float, WS_SC); float* GG = (float*)(F.ws + WS_SC + SC_G); float* MLOC = (float*)(F.ws + WS_SC + SC_MLOC);
    const int t = F.tid >> 3, cg = F.tid & 7, n = F.lane & 31, h = F.lane >> 5, w = F.wave;
    v4u cin[2][4][2];
#pragma unroll
    for (int which = 0; which < 2; ++which)
#pragma unroll
        for (int j = 0; j < 4; ++j) { const int tt = t0 + t - 3 + j; const bf16* rp = QKO + (size_t)(tt < 0 ? 0 : tt) * 4096 + which * 512 + hd * 128 + 16 * cg;
            v4u a = *(const GAS v4u*)rp, b = *(const GAS v4u*)(rp + 8);
            if (tt < 0) { a = (v4u){0u, 0u, 0u, 0u}; b = a; }
            cin[which][j][0] = a; cin[which][j][1] = b; }
    bf16x8 bv[4];
#pragma unroll
    for (int s = 0; s < 4; ++s) bv[s] = *(const GAS bf16x8*)(VT + ((((size_t)(hd * NCH + c) * 256 + 32 * w + n)) << 6) + 16 * s + 8 * h);
    {   float cwv[3];
#pragma unroll
        for (int q = 0; q < 3; ++q) { const int i = F.tid + 512 * q, j = (i >> 8) < 4 ? (i >> 8) : 4, cc = i & 255; const int gcol = (cc < 128) ? hd * 128 + cc : 512 + hd * 128 + (cc - 128);
            cwv[q] = (j < 4) ? F.conv_w[j * 1024 + gcol] : F.conv_b[gcol]; }
#pragma unroll
        for (int q = 0; q < 3; ++q) { const int i = F.tid + 512 * q; if (i < 5 * 256) sCW[i] = cwv[q]; } }
    if (F.wave == 0) {
        const int tl = F.lane; const float f = AIF[(size_t)(t0 + tl) * 8 + 4 + hd], ig = AIF[(size_t)(t0 + tl) * 8 + hd];
        float a = fminf(f, 0.f) - log1pf(__expf(-fabsf(f)));
#pragma unroll
        for (int o = 1; o < 64; o <<= 1) { const float v = __shfl_up(a, o); if (tl >= o) a += v; }
        const float g = __shfl(a, 63), wv = g - a + ig, ml = wave_max(wv);
        sE[tl] = __expf(wv - ml); ACUM[(size_t)hd * M + t0 + tl] = a;
        if (tl == 0) { GG[hd * NCH + c] = g; MLOC[hd * NCH + c] = ml; }
    }
    __syncthreads();
    {
        const float et = sE[t];
#pragma unroll
        for (int which = 0; which < 2; ++which) {
            float acc[16];
#pragma unroll
            for (int i = 0; i < 16; ++i) acc[i] = sCW[4 * 256 + which * 128 + 16 * cg + i];
#pragma unroll
            for (int j = 0; j < 4; ++j) { const v4u a = cin[which][j][0], b = cin[which][j][1];
                const unsigned ww[8] = {a.x, a.y, a.z, a.w, b.x, b.y, b.z, b.w};
#pragma unroll
                for (int i = 0; i < 8; ++i) { acc[2 * i] += sCW[j * 256 + which * 128 + 16 * cg + 2 * i] * bflo(ww[i]); acc[2 * i + 1] += sCW[j * 256 + which * 128 + 16 * cg + 2 * i + 1] * bfhi(ww[i]); } }
#pragma unroll
            for (int i = 0; i < 16; ++i) { acc[i] = acc[i] * sigmoidf_(acc[i]); if (which) acc[i] *= 0.08838834764831845f; }
            bf16* op = WSP(bf16, which ? WS_KC : WS_QC) + (size_t)(t0 + t) * 512 + hd * 128 + 16 * cg;
            v4u o0, o1; o0.x = cvtpk(acc[0], acc[1]); o0.y = cvtpk(acc[2], acc[3]); o0.z = cvtpk(acc[4], acc[5]); o0.w = cvtpk(acc[6], acc[7]);
            o1.x = cvtpk(acc[8], acc[9]); o1.y = cvtpk(acc[10], acc[11]); o1.z = cvtpk(acc[12], acc[13]); o1.w = cvtpk(acc[14], acc[15]);
            *(GAS v4u*)op = o0; *(GAS v4u*)(op + 8) = o1;
            if (which) {
#pragma unroll
                for (int i = 0; i < 16; ++i) sKeT[(16 * cg + i) * 72 + t] = f2bf(et * acc[i]); }
        }
    }
    __syncthreads();
    {
        bf16* cl = WSP(bf16, WS_CLOC) + (((size_t)(hd * 64 + ((32 * w + n) >> 2)) * NCH + c) * 512 + (n & 3) * 128);
        bf16x8 ka_[4][4];
#pragma unroll
        for (int kt = 0; kt < 4; ++kt)
#pragma unroll
            for (int s2 = 0; s2 < 4; ++s2) ka_[kt][s2] = *(const LAS bf16x8*)(sKeT + (32 * kt + n) * 72 + 16 * s2 + 8 * h);
        __builtin_amdgcn_sched_barrier(0);
#pragma unroll
        for (int kt = 0; kt < 4; ++kt) { f32x16 acc;
#pragma unroll
            for (int r = 0; r < 16; ++r) acc[r] = 0.f;
#pragma unroll
            for (int s2 = 0; s2 < 4; ++s2) acc = MFMA32(ka_[kt][s2], bv[s2], acc);
#pragma unroll
            for (int g = 0; g < 4; ++g) { v2u o; o.x = cvtpk(acc[4 * g], acc[4 * g + 1]); o.y = cvtpk(acc[4 * g + 2], acc[4 * g + 3]); *(GAS v2u*)(cl + 32 * kt + 8 * g + 4 * h) = o; } }
        if (F.tid < 128) { float sm = 0.f;
#pragma unroll
            for (int t8 = 0; t8 < 8; ++t8) { const v4u q = *(const LAS v4u*)(sKeT + F.tid * 72 + 8 * t8); sm += (bflo(q.x) + bfhi(q.x)) + (bflo(q.y) + bfhi(q.y)) + (bflo(q.z) + bfhi(q.z)) + (bflo(q.w) + bfhi(q.w)); }
            WSP(float, WS_NLOC)[(size_t)(hd * NCH + c) * 128 + F.tid] = sm; }
    }
    __syncthreads();
}

DI void mlstm_scan(Frame& F) {
    LAS float* sG = (LAS float*)(F.lds + RING_OFF); LAS float* sML = sG + 256; LAS float* sSo = sG + 512; LAS float* sSn = sG + 768;
    const float* GG = (const float*)(F.ws + WS_SC + SC_G); const float* MLOC = (const float*)(F.ws + WS_SC + SC_MLOC); float* MPREV = (float*)(F.ws + WS_SC + SC_MPREV);
    for (int hb = F.bx; hb < 256; hb += F.G) {
        const int hd = hb >> 6, part = hb & 63;
        if (F.tid < 256) { sG[F.tid] = GG[hd * NCH + F.tid]; sML[F.tid] = MLOC[hd * NCH + F.tid]; }
        __syncthreads();
        if (F.wave == 0) { const int l = F.lane; float ga[4], mla[4];
#pragma unroll
            for (int q = 0; q < 4; ++q) { ga[q] = sG[4 * l + q]; mla[q] = sML[4 * l + q]; }
            float A = ga[0], B = mla[0];
#pragma unroll
            for (int q = 1; q < 4; ++q) { B = fmaxf(B + ga[q], mla[q]); A += ga[q]; }
#pragma unroll
            for (int o = 1; o < 64; o <<= 1) { const float Ap = __shfl_up(A, o), Bp = __shfl_up(B, o); if (l >= o) { B = fmaxf(Bp + A, B); A = Ap + A; } }
            const float Ae = __shfl_up(A, 1), Be = __shfl_up(B, 1);
            float m = (l == 0) ? 0.f : fmaxf(Ae, Be);
#pragma unroll
            for (int q = 0; q < 4; ++q) { const int c = 4 * l + q; const float mn = fmaxf(ga[q] + m, mla[q]); sSo[c] = __expf(ga[q] + m - mn); sSn[c] = __expf(mla[q] - mn); if (part == 0) MPREV[hd * NCH + c] = m; m = mn; } }
        __syncthreads();
        if (F.tid < 128) {
            const bf16* cl = WSP(const bf16, WS_CLOC) + (size_t)(hd * 64 + part) * NCH * 512 + 4 * F.tid; bf16* cp = WSP(bf16, WS_CPREV) + (size_t)(hd * 64 + part) * NCH * 512 + 4 * F.tid;
            f32x4 C = {0.f, 0.f, 0.f, 0.f};
            for (int c0 = 0; c0 < NCH; c0 += 16) { v2u v[16];
#pragma unroll
                for (int i = 0; i < 16; ++i) v[i] = *(const GAS v2u*)(cl + (size_t)(c0 + i) * 512);
#pragma unroll
                for (int i = 0; i < 16; ++i) { v2u wq; wq.x = cvtpk(C.x, C.y); wq.y = cvtpk(C.z, C.w); *(GAS v2u*)(cp + (size_t)(c0 + i) * 512) = wq;
                    const f32x4 vf = {bflo(v[i].x), bfhi(v[i].x), bflo(v[i].y), bfhi(v[i].y)}; C = C * sSo[c0 + i] + vf * sSn[c0 + i]; } }
        } else if (F.tid < 256 && part == 0) {
            const int k = F.tid - 128; float N = 0.f; const float* nl = WSP(const float, WS_NLOC) + (size_t)hd * NCH * 128 + k; float* np = WSP(float, WS_NPREV) + (size_t)hd * NCH * 128 + k;
            for (int c0 = 0; c0 < NCH; c0 += 32) { float nv[32];
#pragma unroll
                for (int i = 0; i < 32; ++i) nv[i] = nl[(size_t)(c0 + i) * 128];
#pragma unroll
                for (int i = 0; i < 32; ++i) { np[(size_t)(c0 + i) * 128] = N; N = N * sSo[c0 + i] + nv[i] * sSn[c0 + i]; } }
        }
        __syncthreads();
    }
}

DI void mlstm_c_unit(Frame& F, int hd, int c) {
    LAS float* sB = (LAS float*)(F.lds + RING_OFF);
    LAS float* sMx = sB + 64; LAS float* sSi = sB + 128; LAS float* sEmt = sB + 192; LAS float* sQN = sB + 256;
    LAS float* sRS = sB + 320;
    LAS float* sSS = sB + 448;
    LAS bf16* sQs = (LAS bf16*)(F.lds + RING_OFF + 4096);
    LAS bf16* sP = (LAS bf16*)(F.lds + RING_OFF + 4096 + 64 * 136 * 2);
    const int t0 = CH * c, n = F.lane & 31, h = F.lane >> 5, w = F.wave;
    const bf16* QC = WSP(const bf16, WS_QC); const bf16* KC = WSP(const bf16, WS_KC); const bf16* VT = WSP(const bf16, WS_VT); const float* AIF = WSP(const float, WS_AIF);
    const float* ACUM = WSP(const float, WS_SC); const float* MPREV = (const float*)(F.ws + WS_SC + SC_MPREV);
    const bf16* QKO = WSP(const bf16, WS_QKO); bf16* YA = WSP(bf16, WS_YA);
    const float mprev = MPREV[hd * NCH + c];
    bf16x8 ac[8], av[4];
    { const bf16* cp = WSP(const bf16, WS_CPREV) + (((size_t)(hd * 64 + ((32 * w + n) >> 2)) * NCH + c) * 512 + (n & 3) * 128) + 8 * h; const bf16* vr = VT + ((((size_t)(hd * NCH + c) * 256 + 32 * w + n)) << 6) + 8 * h;
#pragma unroll
      for (int s = 0; s < 8; ++s) ac[s] = *(const GAS bf16x8*)(cp + 16 * s);
#pragma unroll
      for (int s = 0; s < 4; ++s) av[s] = *(const GAS bf16x8*)(vr + 16 * s); }
    v2u ow[2][4]; f32x4 nh[4];
#pragma unroll
    for (int g = 0; g < 4; ++g) { const int v0 = hd * 256 + 32 * w + 8 * g + 4 * h; nh[g] = *(const GAS f32x4*)(F.norm_head + v0);
#pragma unroll
        for (int tt = 0; tt < 2; ++tt) ow[tt][g] = *(const GAS v2u*)(QKO + (size_t)(t0 + 32 * tt + n) * 4096 + 1024 + v0); }
    const int si = w >> 1, ti = w & 1;
    bf16x8 ka[8], qb[8];
    v4u qch[4]; f32x4 npv[8];
    float ga = 0.f, gi = 0.f;
    if (w < 4) {
        if (si <= ti) { const bf16* kr = KC + (size_t)(t0 + 32 * si + n) * 512 + hd * 128 + 8 * h; const bf16* qr = QC + (size_t)(t0 + 32 * ti + n) * 512 + hd * 128 + 8 * h;
#pragma unroll
            for (int s = 0; s < 8; ++s) { ka[s] = *(const GAS bf16x8*)(kr + 16 * s); qb[s] = *(const GAS bf16x8*)(qr + 16 * s); } }
    } else {
        const int u = F.tid - 256, t = u >> 2, qd = u & 3;
        const bf16* qr = QC + (size_t)(t0 + t) * 512 + hd * 128 + 32 * qd; const float* np = WSP(const float, WS_NPREV) + (size_t)(hd * NCH + c) * 128 + 32 * qd;
#pragma unroll
        for (int j = 0; j < 4; ++j) { qch[j] = *(const GAS v4u*)(qr + 8 * j); npv[2 * j] = *(const GAS f32x4*)(np + 8 * j); npv[2 * j + 1] = *(const GAS f32x4*)(np + 8 * j + 4); }
        if (w == 4) { ga = ACUM[(size_t)hd * M + t0 + F.lane]; gi = AIF[(size_t)(t0 + F.lane) * 8 + hd]; }
    }
    if (w == 4) {
        const int t = F.lane; const float bq_ = gi - ga;
        float pm = bq_;
#pragma unroll
        for (int o = 1; o < 64; o <<= 1) { const float v = __shfl_up(pm, o); if (t >= o) pm = fmaxf(pm, v); }
        const float mx = fmaxf(mprev, pm);
        sB[t] = bq_; sMx[t] = mx; sSi[t] = __expf(mprev - mx); sEmt[t] = __expf(-ga - mx);
    }
    __syncthreads();
    if (w < 4) {
        f32x16 acc;
#pragma unroll
        for (int r = 0; r < 16; ++r) acc[r] = 0.f;
        if (si <= ti) {
#pragma unroll
            for (int s = 0; s < 8; ++s) acc = MFMA32(ka[s], qb[s], acc);
        }
        const int t = 32 * ti + n; const float mx = sMx[t]; float rs = 0.f;
#pragma unroll
        for (int g = 0; g < 4; ++g) { float p[4];
#pragma unroll
            for (int i = 0; i < 4; ++i) { const int sI = 32 * si + 8 * g + 4 * h + i; p[i] = (sI <= t) ? __expf(sB[sI] - mx) * acc[4 * g + i] : 0.f; rs += p[i]; }
            v2u wv; wv.x = cvtpk(p[0], p[1]); wv.y = cvtpk(p[2], p[3]); *(LAS v2u*)(sP + t * 72 + 32 * si + 8 * g + 4 * h) = wv; }
        rs += __shfl_xor(rs, 32);
        if (h == 0) sRS[si * 64 + t] = rs;
    } else {
        const int u = F.tid - 256, t = u >> 2, qd = u & 3; const float si_ = sSi[t];
        float dot = 0.f;
#pragma unroll
        for (int j = 0; j < 4; ++j) { const f32x4 n0 = npv[2 * j], n1 = npv[2 * j + 1];
            f32x4 q0, q1; pg8::unpack8(qch[j], q0, q1);
            dot += (q0.x * n0.x + q0.y * n0.y) + (q0.z * n0.z + q0.w * n0.w) + (q1.x * n1.x + q1.y * n1.y) + (q1.z * n1.z + q1.w * n1.w);
            *(LAS v4u*)(sQs + t * 136 + 32 * qd + 8 * j) = pg8::pack8(q0 * si_, q1 * si_); }
        dot += __shfl_xor(dot, 1); dot += __shfl_xor(dot, 2);
        if (qd == 0) sQN[t] = dot;
    }
    __syncthreads();
    {
        f32x16 acc[2];
#pragma unroll
        for (int tt = 0; tt < 2; ++tt) {
            bf16x8 bq_[8], bp_[4];
#pragma unroll
            for (int s = 0; s < 8; ++s) bq_[s] = *(const LAS bf16x8*)(sQs + (32 * tt + n) * 136 + 16 * s + 8 * h);
#pragma unroll
            for (int s = 0; s < 4; ++s) bp_[s] = *(const LAS bf16x8*)(sP + (32 * tt + n) * 72 + 16 * s + 8 * h);
            __builtin_amdgcn_sched_barrier(0);
#pragma unroll
            for (int r = 0; r < 16; ++r) acc[tt][r] = 0.f;
#pragma unroll
            for (int s = 0; s < 8; ++s) acc[tt] = MFMA32(ac[s], bq_[s], acc[tt]);
#pragma unroll
            for (int s = 0; s < 4; ++s) acc[tt] = MFMA32(av[s], bp_[s], acc[tt]);
        }
#pragma unroll
        for (int tt = 0; tt < 2; ++tt) { const int t = 32 * tt + n; const float den = sSi[t] * sQN[t] + sRS[t] + sRS[64 + t]; const float inv = 1.f / fmaxf(fabsf(den), sEmt[t]);
            float ss = 0.f;
#pragma unroll
            for (int r = 0; r < 16; ++r) { acc[tt][r] *= inv; ss += acc[tt][r] * acc[tt][r]; }
            ss += __shfl_xor(ss, 32);
            if (h == 0) sSS[w * 64 + t] = ss; }
        __syncthreads();
#pragma unroll
        for (int tt = 0; tt < 2; ++tt) { const int t = 32 * tt + n; float tot = 0.f;
#pragma unroll
            for (int q = 0; q < 8; ++q) tot += sSS[q * 64 + t];
            const float rn = 1.f / sqrtf(tot * (1.f / 256.f) + EPS);
#pragma unroll
            for (int g = 0; g < 4; ++g) { const int v0 = hd * 256 + 32 * w + 8 * g + 4 * h; const v2u o_ = ow[tt][g];
                const float y0 = acc[tt][4 * g] * rn * nh[g].x * sigmoidf_(bflo(o_.x)), y1 = acc[tt][4 * g + 1] * rn * nh[g].y * sigmoidf_(bfhi(o_.x));
                const float y2 = acc[tt][4 * g + 2] * rn * nh[g].z * sigmoidf_(bflo(o_.y)), y3 = acc[tt][4 * g + 3] * rn * nh[g].w * sigmoidf_(bfhi(o_.y));
                v2u yw; yw.x = cvtpk(y0, y1); yw.y = cvtpk(y2, y3); *(GAS v2u*)(YA + (size_t)(t0 + t) * 1024 + v0) = yw; } }
    }
    __syncthreads();
}

DI void router_block(Frame& F, int rb) {
    LAS float* sLG = (LAS float*)(F.lds + RING_OFF);
    LAS float* sSSq = sLG + 4 * 64 * 33;
    LAS float* sRstd = sSSq + 256;
    LAS int* sCnt = (LAS int*)(sRstd + 64);
    LAS int* sBase = sCnt + 32;
    LAS int* sPE = sBase + 32;
    const int row0 = 64 * rb, n = F.lane & 31, h = F.lane >> 5;
    const bf16* X2 = WSP(const bf16, WS_X2);
    if (F.tid < 32) sCnt[F.tid] = 0;
    {   const int rt = F.wave >> 2, kq = F.wave & 3;
        const bf16* xr = X2 + (size_t)(row0 + 32 * rt + n) * D + 512 * kq + 8 * h;
        const bf16* wh = WSP(const bf16, WS_WRH) + (size_t)n * D + 512 * kq + 8 * h; const bf16* wl = WSP(const bf16, WS_WRL) + (size_t)n * D + 512 * kq + 8 * h;
        f32x16 acc;
#pragma unroll
        for (int r = 0; r < 16; ++r) acc[r] = 0.f;
        float ss = 0.f;
#pragma unroll 1
        for (int s0 = 0; s0 < 32; s0 += 8) {
            v4u xw[8]; bf16x8 bh[8], bl[8];
#pragma unroll
            for (int i = 0; i < 8; ++i) { xw[i] = *(const GAS v4u*)(xr + 16 * (s0 + i)); bh[i] = *(const GAS bf16x8*)(wh + 16 * (s0 + i)); bl[i] = *(const GAS bf16x8*)(wl + 16 * (s0 + i)); }
            __builtin_amdgcn_sched_barrier(0);
#pragma unroll
            for (int i = 0; i < 8; ++i) { f32x4 x0, x1; pg8::unpack8(xw[i], x0, x1);
                ss += (x0.x * x0.x + x0.y * x0.y) + (x0.z * x0.z + x0.w * x0.w) + (x1.x * x1.x + x1.y * x1.y) + (x1.z * x1.z + x1.w * x1.w);
                const bf16x8 ah = __builtin_bit_cast(bf16x8, xw[i]);
                acc = MFMA32(ah, bh[i], acc); acc = MFMA32(ah, bl[i], acc); }
        }
        ss += __shfl_xor(ss, 32);
        if (h == 0) sSSq[kq * 64 + 32 * rt + n] = ss;
#pragma unroll
        for (int r = 0; r < 16; ++r) sLG[(kq * 64 + 32 * rt + crow(r, h)) * 33 + n] = acc[r];
    }
    __syncthreads();
    int myE[4] = {0, 0, 0, 0}, myP[4] = {0, 0, 0, 0};
    {
#pragma unroll
        for (int q = 0; q < 4; ++q) { const int idx = F.tid + 512 * q, r = idx >> 5, e = idx & 31;
            const float ss = (sSSq[r] + sSSq[64 + r]) + (sSSq[128 + r] + sSSq[192 + r]); const float rstd = 1.f / sqrtf(ss * (1.f / D) + EPS); if (e == 0) sRstd[r] = rstd;
            sLG[r * 33 + e] = rstd * ((sLG[r * 33 + e] + sLG[(64 + r) * 33 + e]) + (sLG[(128 + r) * 33 + e] + sLG[(192 + r) * 33 + e])) + F.b_r[e]; } }
    __syncthreads();
    if (F.tid < 64) {
        const int r = F.tid;
        unsigned used = 0u; float tv[4];
#pragma unroll
        for (int k = 0; k < 4; ++k) { float best = -3.4e38f; int bi = 0;
            for (int e = 0; e < NE; ++e) { const float v = sLG[r * 33 + e]; if (!((used >> e) & 1u) && v > best) { best = v; bi = e; } }
            used |= 1u << bi; tv[k] = best; myE[k] = bi; }
        const float e1 = __expf(tv[1] - tv[0]), e2 = __expf(tv[2] - tv[0]), e3 = __expf(tv[3] - tv[0]), inv = 1.f / (1.f + e1 + e2 + e3);
        float* PG = WSP(float, WS_PG) + (size_t)(row0 + r) * 4; *(GAS f32x4*)PG = (f32x4){inv, e1 * inv, e2 * inv, e3 * inv};
#pragma unroll
        for (int k = 0; k < 4; ++k) myP[k] = atomicAdd((int*)&sCnt[myE[k]], 1);
    }
    __syncthreads();
    if (F.tid < 32) sBase[F.tid] = (int)__hip_atomic_fetch_add((unsigned*)(F.ctl + CW_CNT + 64 * F.tid), (unsigned)sCnt[F.tid], RLX_AGENT);
    __syncthreads();
    if (F.tid < 64) { int* PE = WSP(int, WS_PE) + (size_t)(row0 + F.tid) * 4; int* LIST = WSP(int, WS_LIST);
#pragma unroll
        for (int k = 0; k < 4; ++k) { const int pos = sBase[myE[k]] + myP[k]; PE[k] = myE[k] + 32 * pos; LIST[myE[k] * 16384 + pos] = row0 + F.tid; } }
    {
        f32x4 g[8]; { const GAS f32x4* gr = (const GAS f32x4*)F.norm_ffn + F.lane;
#pragma unroll
            for (int j = 0; j < 8; ++j) g[j] = gr[64 * j]; }
#pragma unroll 1
        for (int rr = 0; rr < 64 / NWAVES; rr += 4) {
            v2u xw[4][8]; float rs[4];
#pragma unroll
            for (int q = 0; q < 4; ++q) { const int r = F.wave + NWAVES * (rr + q); const GAS v2u* xr = (const GAS v2u*)(X2 + (size_t)(row0 + r) * D) + F.lane; rs[q] = sRstd[r];
#pragma unroll
                for (int j = 0; j < 8; ++j) xw[q][j] = xr[64 * j]; }
#pragma unroll
            for (int q = 0; q < 4; ++q) { const int r = F.wave + NWAVES * (rr + q);
                if (kFp8Up) { GAS unsigned* o4 = (GAS unsigned*)(F.ws + WS_H2 + (size_t)(row0 + r) * D) + F.lane;
#pragma unroll
                    for (int j = 0; j < 8; ++j) { const f32x4 v = (f32x4){bflo(xw[q][j].x), bfhi(xw[q][j].x), bflo(xw[q][j].y), bfhi(xw[q][j].y)} * rs[q] * g[j]; o4[64 * j] = pk4_fp8(v.x, v.y, v.z, v.w); } }
                else { GAS v2u* o8 = (GAS v2u*)(WSP(bf16, WS_H2) + (size_t)(row0 + r) * D) + F.lane;
#pragma unroll
                    for (int j = 0; j < 8; ++j) { const f32x4 v = (f32x4){bflo(xw[q][j].x), bfhi(xw[q][j].x), bflo(xw[q][j].y), bfhi(xw[q][j].y)} * rs[q] * g[j]; v2u w; w.x = cvtpk(v.x, v.y); w.y = cvtpk(v.z, v.w); o8[64 * j] = w; } }
            }
        }
    }
    __syncthreads();
}

DI int moe_plan(Frame& F, int NT, int gather, const float* bsrc) {
    LAS int* tst = (LAS int*)(F.lds + TST_OFF); LAS int* cntl = tst + 40; LAS int* utab = (LAS int*)(F.lds + UTAB_OFF); LAS unsigned short* tok = (LAS unsigned short*)(F.lds + TOK_OFF); LAS float* bias = (LAS float*)(F.lds + BIAS_OFF);
    if (F.wave == 0) {
        const int cv = (F.lane < 32) ? (int)__hip_atomic_load((unsigned*)(F.ctl + CW_CNT + 64 * (F.lane & 31)), RLX_AGENT) : 0, tl = (cv + 255) >> 8;
        int inc = tl;
#pragma unroll
        for (int o = 1; o < 32; o <<= 1) { const int v = __shfl_up(inc, o); if (F.lane >= o) inc += v; }
        if (F.lane < 32) { cntl[F.lane] = cv; tst[F.lane] = inc - tl; }
        if (F.lane == 31) tst[32] = inc; }
    __syncthreads();
    const int T = tst[32];
    const bool xm = (F.G == 256); const int xq = F.bx & 7, wq = F.bx >> 3, NJ = 256 / NT;
    const int joff = xm ? ((NT == 16) ? 4 * (xq >> 1) + (wq >> 3) : 4 * xq + (wq >> 3)) : 0, pfix = xm ? ((NT == 16) ? 8 * (xq & 1) + (wq & 7) : (wq & 7)) : 0;
    int nu = 0;
    if (xm) { while (nu < MAX_UNITS && NJ * nu + joff < T) ++nu; } else { for (long L = F.bx; L < (long)T * NT && nu < MAX_UNITS; L += F.G) ++nu; }
    if (F.tid < nu) { int j, pnl; if (xm) { j = NJ * F.tid + joff; pnl = pfix; } else { const int L = F.tid * F.G + F.bx; j = L / NT; pnl = L % NT; }
        int e = 0;
        for (int q = 1; q < NE; ++q) if (tst[q] <= j) e = q;
        utab[2 * F.tid] = j; utab[2 * F.tid + 1] = e * NT + pnl; utab[2 * MAX_UNITS + F.tid] = e; utab[3 * MAX_UNITS + F.tid] = (gather == 2) ? j * 256 : 0; }
    __syncthreads();
    const int* LIST = WSP(const int, WS_LIST);
    if (nu > 0) {
        constexpr int NIT = MAX_UNITS * 256 / 512;
        int tv[NIT]; float bv[NIT];
#pragma unroll
        for (int q = 0; q < NIT; ++q) { const int i0 = F.tid + 512 * q, i = (i0 < nu * 256) ? i0 : (F.tid & 255);
            const int ui = i >> 8, r = i & 255, j = utab[2 * ui], e = utab[2 * MAX_UNITS + ui], pnl = utab[2 * ui + 1] - e * NT;
            if (gather == 1) { const int pos = (j - tst[e]) * 256 + r, cnt = cntl[e]; const int t = LIST[e * 16384 + ((pos < cnt) ? pos : 0)]; tv[q] = (pos < cnt) ? t : 0;
                bv[q] = bsrc[(size_t)e * 4096 + (r < 128 ? 0 : 2048) + pnl * 128 + (r & 127)]; }
            else { tv[q] = r; bv[q] = bsrc[(size_t)e * D + pnl * 256 + r]; } }
#pragma unroll
        for (int q = 0; q < NIT; ++q) { const int i0 = F.tid + 512 * q; if (i0 < nu * 256) { tok[i0] = (unsigned short)tv[q]; bias[i0] = bv[q]; } }
    }
    VM_WAIT();
    __syncthreads();
    return nu;
}

DI void final_rows(Frame& F) {
    LAS int* tst = (LAS int*)(F.lds + TST_OFF); LAS int* cntl = tst + 40;
    if (F.wave == 0) {
        const int cv = (F.lane < 32) ? (int)__hip_atomic_load((unsigned*)(F.ctl + CW_CNT + 64 * (F.lane & 31)), RLX_AGENT) : 0, tl = (cv + 255) >> 8;
        int inc = tl;
#pragma unroll
        for (int o = 1; o < 32; o <<= 1) { const int v = __shfl_up(inc, o); if (F.lane >= o) inc += v; }
        if (F.lane < 32) { cntl[F.lane] = cv; tst[F.lane] = inc - tl; }
        if (F.lane == 31) tst[32] = inc; }
    __syncthreads();
    const int gw = F.bx * NWAVES + F.wave, NGW = F.G * NWAVES;
    const bf16* X2 = WSP(const bf16, WS_X2); const int* PE = WSP(const int, WS_PE); const float* PG = WSP(const float, WS_PG);
    f32x4 g[8]; v2u xn[8]; v4i pen; f32x4 pgn;
    { const GAS f32x4* gr = (const GAS f32x4*)F.norm_final + F.lane;
#pragma unroll
      for (int j = 0; j < 8; ++j) g[j] = gr[64 * j];
      const int m0 = gw < M ? gw : 0; const GAS v2u* xr = (const GAS v2u*)(X2 + (size_t)m0 * D) + F.lane;
#pragma unroll
      for (int j = 0; j < 8; ++j) xn[j] = xr[64 * j];
      pen = *(const GAS v4i*)(PE + (size_t)m0 * 4); pgn = *(const GAS f32x4*)(PG + (size_t)m0 * 4); }
    for (int m = gw; m < M; m += NGW) {
        f32x4 v[8]; const v4i pe4 = pen; const f32x4 pg4 = pgn;
#pragma unroll
        for (int j = 0; j < 8; ++j) v[j] = (f32x4){bflo(xn[j].x), bfhi(xn[j].x), bflo(xn[j].y), bfhi(xn[j].y)};
        unsigned yw[4][8];
#pragma unroll
        for (int k = 0; k < 4; ++k) { const int pe = __builtin_amdgcn_readfirstlane(pe4[k]); const int e = pe & 31, pos = pe >> 5;
            const GAS unsigned* yr = (const GAS unsigned*)(F.ws + WS_YM + ((size_t)tst[e] * 256 + pos) * D) + F.lane;
#pragma unroll
            for (int j = 0; j < 8; ++j) yw[k][j] = yr[64 * j]; }
        { const int mn = (m + NGW < M) ? m + NGW : m; const GAS v2u* xr = (const GAS v2u*)(X2 + (size_t)mn * D) + F.lane;
#pragma unroll
          for (int j = 0; j < 8; ++j) xn[j] = xr[64 * j];
          pen = *(const GAS v4i*)(PE + (size_t)mn * 4); pgn = *(const GAS f32x4*)(PG + (size_t)mn * 4); }
#pragma unroll
        for (int k = 0; k < 4; ++k) { const float gk = pg4[k] * YM_INV;
#pragma unroll
            for (int j = 0; j < 8; ++j) { const int w = (int)yw[k][j]; const f32x2 lo = __builtin_amdgcn_cvt_pk_f32_fp8(w, false), hi = __builtin_amdgcn_cvt_pk_f32_fp8(w, true);
                v[j].x += gk * lo.x; v[j].y += gk * lo.y; v[j].z += gk * hi.x; v[j].w += gk * hi.y; } }
        float ss = 0.f;
#pragma unroll
        for (int j = 0; j < 8; ++j) ss += (v[j].x * v[j].x + v[j].y * v[j].y) + (v[j].z * v[j].z + v[j].w * v[j].w);
        const float rstd = 1.f / sqrtf(wave_sum(ss) * (1.f / D) + EPS);
        GAS f32x4* orow = (GAS f32x4*)(F.out + (size_t)m * D) + F.lane;
#pragma unroll
        for (int j = 0; j < 8; ++j) orow[64 * j] = v[j] * rstd * g[j];
    }
}

struct Args { const float* in[20]; float* out; unsigned char* ws; int ph_lo, ph_hi, li, pad; };
__global__ void __launch_bounds__(NWAVES * 64, 2) mk_fwd(Args args) {
    extern __shared__ __attribute__((aligned(16))) unsigned char lds[];
    Frame F;
    F.lds = (LAS unsigned char*)lds; F.ws = args.ws; F.ctl = (gu32*)(args.ws + WS_CTL);
    F.tid = threadIdx.x; F.lane = F.tid & 63; F.wave = __builtin_amdgcn_readfirstlane(F.tid >> 6); F.G = gridDim.x; F.bx = blockIdx.x;
    F.x = args.in[0]; F.norm_mix = args.in[1]; F.w_in = args.in[2]; F.conv_w = args.in[3]; F.conv_b = args.in[4]; F.b_if = args.in[5]; F.norm_head = args.in[6]; F.w_pa = args.in[7]; F.w_pb = args.in[8];
    F.w_mg = args.in[9]; F.b_mg = args.in[10]; F.w_out = args.in[11]; F.norm_ffn = args.in[12]; F.w_r = args.in[13]; F.b_r = args.in[14]; F.w_gu = args.in[15]; F.b_gu = args.in[16]; F.w_dn = args.in[17];
    F.b_dn = args.in[18]; F.norm_final = args.in[19]; F.out = args.out;
    volatile LAS unsigned* MISC = (volatile LAS unsigned*)(F.lds + MISC_OFF);
    if (F.tid < 32) MISC[F.tid] = 0u;
    __syncthreads();
    XcdBarrier bar; bar.bar = (unsigned*)(F.ctl + CW_BAR); bar.x = 0; bar.st = nullptr;
    if (N_LAUNCHES != PER_PHASE) bar = xcd_barrier_post((unsigned*)(F.ctl + CW_BAR), MISC + 8);
#define GRID_BAR() do { if (N_LAUNCHES != PER_PHASE) xcd_barrier(bar); } while (0)
    const int lo = args.ph_lo, hi = args.ph_hi;
#ifndef PHMASK
#define PHMASK 0x7ff
#endif
#define IN(k) (((PHMASK >> (k)) & 1) && lo <= (k) && (k) < hi)
#define BOTH(k) (IN(k) && IN((k) + 1))
#ifndef DUP_MASK
#define DUP_MASK 0
#endif
#define REPS(k) (((DUP_MASK >> (k)) & 1) ? 2 : 1)
#define PH_BEGIN(k) if (IN(k)) { _Pragma("unroll") for (int rep_ = 0; rep_ < REPS(k); ++rep_) {
#define PH_END(k) if (BOTH(k) || rep_ + 1 < REPS(k)) GRID_BAR(); } }

    PH_BEGIN(0) p0_prologue(F); PH_END(0)

    PH_BEGIN(1)
        if (F.bx >= NCONV_WG && F.G > NCONV_WG) { const int Gg = F.G - NCONV_WG, cg = F.bx - NCONV_WG;
#define P1_QKO() { pg8::Gemm g{WSP(const bf16, WS_H), WSP(const bf16, WS_W1N), M, 4096, D}; pg8::StaticOrder S; S.init(M, 4096, Gg, cg); \
          pg8::EpiPlain E{WSP(bf16, WS_QKO), 4096}; \
          pg8::gemm_phase<pg8::EpiPlain, pg8::StaticOrder, true, false>(F.lds + RING_OFF, g, S, E); }
#define P1_GATE() { pg8::Gemm g{WSP(const bf16, WS_H8), WSP(const bf16, WS_WMG8), M, 4096, D / 2}; pg8::StaticOrder S; S.init(M, 4096, Gg, cg); S.rowbytes = D; \
          pg8::EpiGate E{WSP(bf16, WS_GT), F.b_mg}; \
          pg8::gemm_phase<pg8::EpiGate, pg8::StaticOrder, true, true, true>(F.lds + RING_OFF, g, S, E); }
#define P1_VT() { pg8::Gemm g{WSP(const bf16, WS_W1V), WSP(const bf16, WS_H), 2048, M, D}; pg8::StaticOrder S; S.init(2048, M, Gg, cg); \
          pg8::EpiVT E{WSP(bf16, WS_VT)}; \
          pg8::gemm_phase<pg8::EpiVT, pg8::StaticOrder, true, false>(F.lds + RING_OFF, g, S, E); }
        if ((F.bx >> 3) & 1) { P1_GATE() P1_VT() P1_QKO() } else { P1_QKO() P1_GATE() P1_VT() }
#undef P1_QKO
#undef P1_GATE
#undef P1_VT
        }
        conv_queue(F);
    PH_END(1)

    PH_BEGIN(2)
        for (int u = F.bx; u < 4 * NCH; u += F.G) mlstm_a_unit(F, u >> 8, u & 255);
        { const int gw = F.bx * NWAVES + F.wave, NGW = F.G * NWAVES;
          for (int u = gw; u < 8 * (M / 32); u += NGW) attn_wave_unit(WSP(const bf16, WS_QKO), WSP(const bf16, WS_VT), WSP(bf16, WS_YB), u / (M / 32), u % (M / 32), F.lane, F.lds + RING_OFF + F.wave * 18944); }
    PH_END(2)

    PH_BEGIN(3) mlstm_scan(F); PH_END(3)

    PH_BEGIN(4) for (int u = F.bx; u < 4 * NCH; u += F.G) mlstm_c_unit(F, u >> 8, u & 255); PH_END(4)

    PH_BEGIN(5)
        { pg8::Gemm g{WSP(const bf16, WS_YA), WSP(const bf16, WS_WPA), M, D, 1024}; pg8::StaticOrder S; S.init(M, D, F.G, F.bx);
          pg8::EpiMix<false> E{WSP(bf16, WS_MIX), WSP(bf16, WS_X2 + 64 * MiB), WSP(const bf16, WS_GT), 0};
          pg8::gemm_phase<pg8::EpiMix<false>, pg8::StaticOrder, true, false>(F.lds + RING_OFF, g, S, E); }
        { pg8::Gemm g{WSP(const bf16, WS_YB), WSP(const bf16, WS_WPB), M, D, 1024}; pg8::StaticOrder S; S.init(M, D, F.G, F.bx);
          pg8::EpiMix<true> E{WSP(bf16, WS_MIX), WSP(bf16, WS_X2 + 64 * MiB), WSP(const bf16, WS_GT), 8};
          pg8::gemm_phase<pg8::EpiMix<true>, pg8::StaticOrder, true, false>(F.lds + RING_OFF, g, S, E); }
    PH_END(5)

    PH_BEGIN(6)
        pg8::Gemm g{WSP(const bf16, WS_MIX), WSP(const bf16, WS_WOT), M, D, D}; pg8::StaticOrder S; S.init(M, D, F.G, F.bx);
        pg8::EpiX2 E{F.x, WSP(bf16, WS_X2)};
        pg8::gemm_phase<pg8::EpiX2, pg8::StaticOrder, true, false>(F.lds + RING_OFF, g, S, E);
    PH_END(6)

    PH_BEGIN(7) for (int rb = F.bx; rb < M / 64; rb += F.G) router_block(F, rb); PH_END(7)

    PH_BEGIN(8)
        const int nu = moe_plan(F, 16, 1, F.b_gu);
        pg8::Gemm g{WSP(const bf16, WS_H2), WSP(const bf16, WS_WGU), M, 4096, kFp8Up ? D / 2 : D};
        pg8::MoeOrder S{(const LAS int*)(F.lds + UTAB_OFF), (const LAS unsigned short*)(F.lds + TOK_OFF), __builtin_amdgcn_readfirstlane(nu), kFp8Up ? (unsigned)D : 2u * D, MAX_UNITS};
        pg8::EpiMoeUp<kFp8Dn> E{WSP(bf16, WS_ACT), (const LAS float*)(F.lds + BIAS_OFF)};
        pg8::gemm_phase<pg8::EpiMoeUp<kFp8Dn>, pg8::MoeOrder, true, true, kFp8Up>(F.lds + RING_OFF, g, S, E);
    PH_END(8)

    PH_BEGIN(9)
        const int nu = moe_plan(F, 8, 2, F.b_dn);
        pg8::Gemm g{WSP(const bf16, WS_ACT), WSP(const bf16, WS_WDN), ACT_ROWS, D, kFp8Dn ? DFF / 2 : DFF};
        pg8::MoeOrder S{(const LAS int*)(F.lds + UTAB_OFF), (const LAS unsigned short*)(F.lds + TOK_OFF), __builtin_amdgcn_readfirstlane(nu), kFp8Dn ? (unsigned)DFF : 2u * DFF, MAX_UNITS};
        pg8::EpiMoeDn E{F.ws + WS_YM, (const LAS float*)(F.lds + BIAS_OFF)};
        pg8::gemm_phase<pg8::EpiMoeDn, pg8::MoeOrder, true, true, kFp8Dn>(F.lds + RING_OFF, g, S, E);
    PH_END(9)

    PH_BEGIN(10) final_rows(F); PH_END(10)
#undef IN
#undef BOTH
}

extern "C" void kernel_launch(void* const* d_in, const int* in_sizes, int n_in, void* d_out, int out_size, void* d_ws, size_t ws_size, hipStream_t stream) {
    static int grid = 0;
    if (grid == 0) {
        if (n_in != 20 || out_size != M * D || ws_size < WS_END) { fprintf(stderr, "kernel_launch: unexpected problem (n_in %d, out %d, ws %zu < %zu)\n", n_in, out_size, ws_size, (size_t)WS_END); grid = -1; return; }
        int dev = 0, cus = 0, per_cu = 0;
        if (hipGetDevice(&dev) != hipSuccess || hipDeviceGetAttribute(&cus, hipDeviceAttributeMultiprocessorCount, dev) != hipSuccess) { grid = -1; return; }
        if (hipFuncSetAttribute((const void*)mk_fwd, hipFuncAttributeMaxDynamicSharedMemorySize, LDS_BYTES) != hipSuccess) { fprintf(stderr, "kernel_launch: hipFuncSetAttribute failed\n"); grid = -1; return; }
        if (hipOccupancyMaxActiveBlocksPerMultiprocessor(&per_cu, (const void*)mk_fwd, NWAVES * 64, LDS_BYTES) != hipSuccess || per_cu < 1) { fprintf(stderr, "kernel_launch: occupancy query reports %d\n", per_cu); }
        (void)hipGetLastError();
        grid = cus;
        if (grid > 256) grid = 256;
    }
    if (grid < 0) return;
    (void)hipMemsetAsync((char*)d_ws + WS_CTL, 0, CTL_ZERO_BYTES, stream);
    Args a{};
    for (int i = 0; i < 20; ++i) a.in[i] = (const float*)d_in[i];
    a.out = (float*)d_out; a.ws = (unsigned char*)d_ws;
    if (N_LAUNCHES == 1) { a.ph_lo = 0; a.ph_hi = PER_PHASE; a.li = 0; hipLaunchKernelGGL(mk_fwd, dim3(grid), dim3(NWAVES * 64), LDS_BYTES, stream, a); }
    else for (int li = 0; li < PER_PHASE; ++li) { a.ph_lo = li; a.ph_hi = li + 1; a.li = li; hipLaunchKernelGGL(mk_fwd, dim3(grid), dim3(NWAVES * 64), LDS_BYTES, stream, a); }
    const hipError_t le = hipPeekAtLastError();
    if (le != hipSuccess) fprintf(stderr, "kernel_launch: launch failed: %s\n", hipGetErrorName(le));
}
```

```cpp
#include <hip/hip_runtime.h>
#include <cstdio>
#include <type_traits>

#define GAS __attribute__((address_space(1)))
#define LAS __attribute__((address_space(3)))
typedef unsigned short bf16;
typedef unsigned v4u __attribute__((ext_vector_type(4)));
typedef unsigned v2u __attribute__((ext_vector_type(2)));
typedef float f32x4 __attribute__((ext_vector_type(4)));
typedef float f32x2 __attribute__((ext_vector_type(2)));
typedef float f32x16 __attribute__((ext_vector_type(16)));
typedef short bf16x8 __attribute__((ext_vector_type(8)));
typedef int v4i __attribute__((ext_vector_type(4)));
typedef int v8i __attribute__((ext_vector_type(8)));
typedef short s16x16 __attribute__((ext_vector_type(16)));
typedef short bf16x4 __attribute__((ext_vector_type(4)));
typedef __bf16 bf16x2_t __attribute__((ext_vector_type(2)));
typedef GAS unsigned gu32;
#define RLX_AGENT __ATOMIC_RELAXED, __HIP_MEMORY_SCOPE_AGENT
#define LDS_WAIT() asm volatile("s_waitcnt lgkmcnt(0)" ::: "memory")
#define VM_WAIT() asm volatile("s_waitcnt vmcnt(0)" ::: "memory")
#define DI __device__ __forceinline__

DI unsigned cvtpk(float lo, float hi) { f32x2 v = {lo, hi}; bf16x2_t b = __builtin_convertvector(v, bf16x2_t); return __builtin_bit_cast(unsigned, b); }
DI float bflo(unsigned w) { return __builtin_bit_cast(float, w << 16); }
DI float bfhi(unsigned w) { return __builtin_bit_cast(float, w & 0xffff0000u); }
DI float bf2f(bf16 b) { return __builtin_bit_cast(float, ((unsigned)b) << 16); }
DI bf16 f2bf(float f) { return (bf16)(cvtpk(f, 0.f) & 0xffffu); }
DI unsigned pk4_fp8(float a, float b, float c, float d) { int w = 0; w = __builtin_amdgcn_cvt_pk_fp8_f32(a, b, w, false); w = __builtin_amdgcn_cvt_pk_fp8_f32(c, d, w, true); return (unsigned)w; }
DI float sigmoidf_(float x) { return __builtin_amdgcn_rcpf(1.f + __expf(-x)); }
DI float wave_sum(float v) {
#pragma unroll
    for (int o = 1; o < 64; o <<= 1) v += __shfl_xor(v, o);
    return v;
}
DI float wave_max(float v) {
#pragma unroll
    for (int o = 1; o < 64; o <<= 1) v = fmaxf(v, __shfl_xor(v, o));
    return v;
}
DI int crow(int reg, int h) { return (reg & 3) + 8 * (reg >> 2) + 4 * h; }
#define MFMA32(a, b, c) __builtin_amdgcn_mfma_f32_32x32x16_bf16((a), (b), (c), 0, 0, 0)

constexpr int M = 16384, D = 2048;
constexpr int INC = 6152;
constexpr int NE = 32, DFF = 2048, TOPK = 4;
constexpr int NCH = 256, CH = 64;
constexpr float EPS = 1e-5f;
constexpr size_t VT_B = (size_t)4 * 256 * 256 * 64;
constexpr int ACT_ROWS = 65536 + 32 * 256;
constexpr float YM_SCALE = 16.f, YM_INV = 1.f / 16.f;

#ifndef FP8_OUT
#define FP8_OUT 1
#endif
constexpr bool kFp8Out = FP8_OUT;
namespace pg8 {
#define PG8_LAS __attribute__((address_space(3)))
typedef unsigned short bf16_t;
typedef unsigned u32x4 __attribute__((ext_vector_type(4)));
constexpr int BM = 256, BK = 64, HALF = 128, HTB = HALF * BK * 2, STAGE_BYTES = 8 * HTB, NXCD = 8, WGM = 4;
__host__ __device__ __forceinline__ int lds_byte(int r, int c) { const int st = (r >> 4) * 2 + (c >> 5), rr = r & 15, cc = c & 31, ob = rr * 64 + cc * 2; return st * 1024 + (ob ^ (((ob >> 9) & 1) << 5)); }
__host__ __device__ __forceinline__ void stage_rc(int b, int& R, int& C) { const int st = b / 1024, sb = b % 1024, swz = sb ^ (((sb >> 9) & 1) << 5); R = (st >> 1) * 16 + swz / 64; C = (st & 1) * 32 + (swz % 64) / 2; }
__host__ __device__ __forceinline__ int perm32(int rho) { const int n = rho >> 4, i = rho & 15; return 8 * (i >> 2) + 4 * n + (i & 3); }

struct Unit { int pm, pn, ui; };
struct Gemm { const bf16_t* A; const bf16_t* Bt; int M, N, K; };

struct StaticOrder {
    int nM, nN, nwg, G, c;
    __device__ void init(int M_, int N_, int G_, int c_) { nM = M_ / BM; nN = N_ / BM; nwg = nM * nN; G = G_; c = c_; }
    __device__ bool next(int i, Unit& u) const {
        const long L = (long)i * G + c; if (L >= nwg) return false;
        int wgid = (int)L; { const int q = nwg / NXCD, r = nwg % NXCD, xcd = wgid % NXCD, off = wgid / NXCD; wgid = (xcd < r ? xcd * (q + 1) : r * (q + 1) + (xcd - r) * q) + off; }
        const int nig = WGM * nN, gid = wgid / nig, fm = gid * WGM, gsz = (nM - fm) < WGM ? (nM - fm) : WGM;
        u.pm = __builtin_amdgcn_readfirstlane(fm + ((wgid % nig) % gsz)); u.pn = __builtin_amdgcn_readfirstlane((wgid % nig) / gsz); u.ui = i; return true;
    }
    unsigned rowbytes;
    __device__ __forceinline__ unsigned tok(int i, int r) const { Unit u; (void)next(i, u); return (unsigned)(u.pm * BM + r) * rowbytes; }
};
struct MoeOrder {
    const PG8_LAS int* tab; const PG8_LAS unsigned short* tok16; int n; unsigned rowbytes; int maxu;
    __device__ __forceinline__ bool next(int i, Unit& u) const { if (i >= n) return false; u.pm = __builtin_amdgcn_readfirstlane(tab[2 * i]); u.pn = __builtin_amdgcn_readfirstlane(tab[2 * i + 1]); u.ui = i; return true; }
    __device__ __forceinline__ unsigned tok(int i, int r) const { return ((unsigned)tab[3 * maxu + i] + (unsigned)tok16[i * 256 + r]) * rowbytes; }
};

__device__ __forceinline__ f32x4 mma8(const bf16x8& b0, const bf16x8& b1, const bf16x8& a0, const bf16x8& a1, const f32x4& c) {
    const v8i b = __builtin_shufflevector(__builtin_bit_cast(v4i, b0), __builtin_bit_cast(v4i, b1), 0, 1, 2, 3, 4, 5, 6, 7), a = __builtin_shufflevector(__builtin_bit_cast(v4i, a0), __builtin_bit_cast(v4i, a1), 0, 1, 2, 3, 4, 5, 6, 7);
    return __builtin_amdgcn_mfma_scale_f32_16x16x128_f8f6f4(b, a, c, 0, 0, 0, 0x79797979, 0, 0x7f7f7f7f); }
template <class Epi, class Sched, bool ALIGN_EPI, bool GATHER, bool FP8 = false>
__device__ __forceinline__ void gemm_phase(PG8_LAS unsigned char* lds, const Gemm g, const Sched& S, const Epi& E) {
    const int tid = threadIdx.x, wid = __builtin_amdgcn_readfirstlane(tid >> 6), lane = tid & 63, wr = wid >> 2, wc = wid & 3, fr = lane & 15, fq = lane >> 4;
    const int K = g.K, nt = K / BK;
    unsigned voffA[2], voffB[2]; int rowA[2]; unsigned colA[2];
#pragma unroll
    for (int i = 0; i < 2; ++i) { int R, C; stage_rc(tid * 16 + i * 8192, R, C); const int Rb = Epi::PERM ? ((R & ~31) + perm32(R & 31)) : R;
        voffA[i] = (unsigned)(R * K + C) * 2u; voffB[i] = (unsigned)(Rb * K + C) * 2u; rowA[i] = R; colA[i] = (unsigned)C * 2u; }
    const unsigned kstep = (unsigned)(BK * 2);
    const unsigned hstep = (unsigned)HALF * K * 2;
    const unsigned tstep = 2 * hstep;
    const unsigned ldsw = (unsigned)wid * 1024u;
    const int aoff = lds_byte(wr * 64 + fr, fq * 8), boff = lds_byte(wc * 32 + fr, fq * 8);
    constexpr int KSTR = 1024;
#define PG8_SA(b, h) (((b) * 2 + (h)) * HTB)
#define PG8_SB(b, h) ((4 + (b) * 2 + (h)) * HTB)
    const __amdgpu_buffer_rsrc_t rsA = __builtin_amdgcn_make_buffer_rsrc((void*)g.A, 0, 0xffffffffu, 0x00020000), rsB = __builtin_amdgcn_make_buffer_rsrc((void*)g.Bt, 0, 0xffffffffu, 0x00020000);
#define PG8_STAGE(bufoff, soff, voff) do { _Pragma("unroll") for (int _i = 0; _i < 2; ++_i) \
        __builtin_amdgcn_raw_ptr_buffer_load_lds(rsB, (PG8_LAS unsigned*)(lds + (bufoff) + ldsw + _i * 8192), 16, (int)(voff)[_i], (int)(soff), 0, 0); } while (0)
#define PG8_STAGE_A(bufoff, ubase, V, kb, h) do { _Pragma("unroll") for (int _i = 0; _i < 2; ++_i) { \
        if constexpr (GATHER) __builtin_amdgcn_raw_ptr_buffer_load_lds(rsA, (PG8_LAS unsigned*)(lds + (bufoff) + ldsw + _i * 8192), 16, (int)(V)[h][_i], (int)(kb), 0, 0); \
        else __builtin_amdgcn_raw_ptr_buffer_load_lds(rsA, (PG8_LAS unsigned*)(lds + (bufoff) + ldsw + _i * 8192), 16, (int)voffA[_i], (int)((ubase) + (kb) + (unsigned)(h) * hstep), 0, 0); } } while (0)
#define PG8_LDA(dst, b, h) do { _Pragma("unroll") for (int m = 0; m < 4; ++m) _Pragma("unroll") for (int k = 0; k < 2; ++k) dst[m][k] = *(const PG8_LAS bf16x8*)(lds + PG8_SA(b, h) + aoff + m * 2048 + k * KSTR); } while (0)
#define PG8_LDB(dst, b, h) do { _Pragma("unroll") for (int n = 0; n < 2; ++n) _Pragma("unroll") for (int k = 0; k < 2; ++k) dst[n][k] = *(const PG8_LAS bf16x8*)(lds + PG8_SB(b, h) + boff + n * 2048 + k * KSTR); } while (0)
#define PG8_MMA(ai, bj, At, Bt) do { __builtin_amdgcn_s_setprio(1); _Pragma("unroll") for (int m = 0; m < 4; ++m) _Pragma("unroll") for (int n = 0; n < 2; ++n) { \
        if constexpr (FP8) acc[ai][bj][m][n] = mma8(Bt[n][0], Bt[n][1], At[m][0], At[m][1], acc[ai][bj][m][n]); \
        else { _Pragma("unroll") for (int k = 0; k < 2; ++k) acc[ai][bj][m][n] = __builtin_amdgcn_mfma_f32_16x16x32_bf16(Bt[n][k], At[m][k], acc[ai][bj][m][n], 0, 0, 0); } } __builtin_amdgcn_s_setprio(0); } while (0)
#define PG8_WAIT_V(n) asm volatile("s_waitcnt vmcnt(" #n ")" ::: "memory")
#define PG8_WAIT_L(n) asm volatile("s_waitcnt lgkmcnt(" #n ")" ::: "memory")
#define PG8_BAR __builtin_amdgcn_s_barrier()
#define PG8_SCHED __builtin_amdgcn_sched_barrier(0)
    Unit cur, nxt; int ui = 0;
    if (!S.next(0, cur)) return;
    f32x4 acc[2][2][4][2];
#pragma unroll
    for (int a = 0; a < 2; ++a)
#pragma unroll
        for (int b = 0; b < 2; ++b)
#pragma unroll
            for (int m = 0; m < 4; ++m)
#pragma unroll
                for (int n = 0; n < 2; ++n) acc[a][b][m][n] = (f32x4){0.f, 0.f, 0.f, 0.f};
    bf16x8 At[4][2], B0[2][2], B1[2][2];
    unsigned vg[2][2] = {{0u, 0u}, {0u, 0u}};
    if constexpr (GATHER) {
#pragma unroll
        for (int h = 0; h < 2; ++h)
#pragma unroll
            for (int i = 0; i < 2; ++i) vg[h][i] = S.tok(0, h * HALF + rowA[i]) + colA[i];
    }
    unsigned cA = GATHER ? 0u : (unsigned)cur.pm * tstep, cB = (unsigned)cur.pn * tstep;
    PG8_STAGE(PG8_SB(0, 0), cB, voffB); PG8_STAGE(PG8_SB(0, 1), cB + hstep, voffB); PG8_STAGE_A(PG8_SA(0, 0), cA, vg, 0u, 0); PG8_STAGE_A(PG8_SA(0, 1), cA, vg, 0u, 1);
    if (wr == 1) PG8_BAR;
    PG8_WAIT_V(2); PG8_BAR;
    PG8_STAGE(PG8_SB(1, 0), cB + kstep, voffB); PG8_STAGE_A(PG8_SA(1, 0), cA, vg, kstep, 0); PG8_STAGE(PG8_SB(1, 1), cB + hstep + kstep, voffB);
    PG8_WAIT_V(6); PG8_BAR;
    for (;;) {
        const bool has_next = S.next(ui + 1, nxt);
        const unsigned nA = GATHER ? 0u : (has_next ? (unsigned)nxt.pm * tstep : cA), nB = has_next ? (unsigned)nxt.pn * tstep : cB;
        for (int t = 0; t < nt; t += 2) {
            const bool last = (t == nt - 2);
            const unsigned k1 = (unsigned)(t + 1) * kstep;
            const unsigned a2b = last ? nA : cA; const unsigned k2 = last ? 0u : (unsigned)(t + 2) * kstep, k3 = k2 + kstep;
            const unsigned b2 = last ? nB : cB + (unsigned)(t + 2) * kstep; const unsigned b3 = b2 + kstep;
            PG8_LDB(B0, 0, 0); PG8_LDB(B1, 0, 1); PG8_SCHED; PG8_LDA(At, 0, 0); PG8_STAGE_A(PG8_SA(1, 1), cA, vg, k1, 1);
            if constexpr (GATHER) { if (last && has_next) {
#pragma unroll
                for (int h = 0; h < 2; ++h)
#pragma unroll
                    for (int i = 0; i < 2; ++i) vg[h][i] = S.tok(ui + 1, h * HALF + rowA[i]) + colA[i]; } }
            PG8_WAIT_V(8); PG8_WAIT_L(0); PG8_BAR; PG8_MMA(0, 0, At, B0); PG8_MMA(0, 1, At, B1); PG8_BAR; PG8_SCHED;
            PG8_LDA(At, 0, 1); PG8_STAGE(PG8_SB(0, 0), b2, voffB); PG8_STAGE(PG8_SB(0, 1), b2 + hstep, voffB); PG8_STAGE_A(PG8_SA(0, 0), a2b, vg, k2, 0);
            PG8_WAIT_V(8); PG8_WAIT_L(0); PG8_BAR; PG8_MMA(1, 0, At, B0); PG8_MMA(1, 1, At, B1); PG8_BAR; PG8_SCHED;
            PG8_LDB(B0, 1, 0); PG8_LDB(B1, 1, 1); PG8_SCHED; PG8_LDA(At, 1, 0); PG8_STAGE_A(PG8_SA(0, 1), a2b, vg, k2, 1);
            PG8_WAIT_V(8); PG8_WAIT_L(0); PG8_BAR; PG8_MMA(0, 0, At, B0); PG8_MMA(0, 1, At, B1); PG8_BAR; PG8_SCHED;
            PG8_LDA(At, 1, 1); PG8_STAGE(PG8_SB(1, 0), b3, voffB); PG8_STAGE(PG8_SB(1, 1), b3 + hstep, voffB); PG8_STAGE_A(PG8_SA(1, 0), a2b, vg, k3, 0);
            PG8_WAIT_V(8); PG8_WAIT_L(0); PG8_BAR; PG8_MMA(1, 0, At, B0); PG8_MMA(1, 1, At, B1); PG8_BAR; PG8_SCHED;
        }
        if constexpr (ALIGN_EPI) { if (wr == 0) PG8_BAR; }
        E(acc, cur, wr, wc, fr, fq);
        if (!has_next) break;
#pragma unroll
        for (int a = 0; a < 2; ++a)
#pragma unroll
            for (int b = 0; b < 2; ++b)
#pragma unroll
                for (int m = 0; m < 4; ++m)
#pragma unroll
                    for (int n = 0; n < 2; ++n) acc[a][b][m][n] = (f32x4){0.f, 0.f, 0.f, 0.f};
        cur = nxt; cA = nA; cB = nB; ++ui;
        if constexpr (ALIGN_EPI) { if (wr == 1) PG8_BAR; }
    }
    PG8_WAIT_V(0);
    if constexpr (!ALIGN_EPI) { if (wr == 0) PG8_BAR; }
    PG8_BAR;
#undef PG8_SA
#undef PG8_SB
#undef PG8_STAGE
#undef PG8_STAGE_A
#undef PG8_LDA
#undef PG8_LDB
#undef PG8_MMA
#undef PG8_WAIT_V
#undef PG8_WAIT_L
#undef PG8_BAR
#undef PG8_SCHED
}

#define EPI_ROWS(...) _Pragma("unroll") for (int ai = 0; ai < 2; ++ai) _Pragma("unroll") for (int m = 0; m < 4; ++m) { const int row = u.pm * BM + wr * 64 + fr + ai * HALF + m * 16; \
        _Pragma("unroll") for (int bj = 0; bj < 2; ++bj) { __VA_ARGS__ } }
DI u32x4 pack8(const f32x4& v0, const f32x4& v1) { u32x4 w; w.x = cvtpk(v0[0], v0[1]); w.y = cvtpk(v0[2], v0[3]); w.z = cvtpk(v1[0], v1[1]); w.w = cvtpk(v1[2], v1[3]); return w; }
DI void unpack8(const u32x4& w, f32x4& v0, f32x4& v1) { v0 = (f32x4){bflo(w.x), bfhi(w.x), bflo(w.y), bfhi(w.y)}; v1 = (f32x4){bflo(w.z), bfhi(w.z), bflo(w.w), bfhi(w.w)}; }

struct EpiPlain { static constexpr bool PERM = true; bf16_t* O; int ldc;
    __device__ __forceinline__ void operator()(const f32x4 (&acc)[2][2][4][2], const Unit& u, int wr, int wc, int fr, int fq) const {
        const int col0 = u.pn * BM + wc * 32 + 8 * fq;
        EPI_ROWS( *(u32x4*)(O + (size_t)row * ldc + col0 + bj * HALF) = pack8(acc[ai][bj][m][0], acc[ai][bj][m][1]); )
    } };
struct EpiVT { static constexpr bool PERM = true; bf16_t* VT;
    __device__ __forceinline__ void operator()(const f32x4 (&acc)[2][2][4][2], const Unit& u, int wr, int wc, int fr, int fq) const {
        const int col0 = u.pn * BM + wc * 32 + 8 * fq;
        if (u.pm < 4) {
            EPI_ROWS( const int col = col0 + bj * HALF, hd = row >> 8, v = row & 255;
                *(u32x4*)(VT + ((((size_t)(hd * 256 + (col >> 6)) * 256 + v) << 6) + (col & 63))) = pack8(acc[ai][bj][m][0], acc[ai][bj][m][1]); )
        } else {
            EPI_ROWS( const int col = col0 + bj * HALF, r2 = row - 1024, hd = r2 >> 7, d = r2 & 127;
                *(u32x4*)(VT + VT_B + ((((size_t)(hd * 512 + (col >> 5)) * 128 + d) << 5) + (col & 31))) = pack8(acc[ai][bj][m][0], acc[ai][bj][m][1]); )
        }
    } };
struct EpiGate { static constexpr bool PERM = true; bf16_t* GT; const float* bmg;
    __device__ __forceinline__ void operator()(const f32x4 (&acc)[2][2][4][2], const Unit& u, int wr, int wc, int fr, int fq) const {
        const int col0 = u.pn * BM + wc * 32 + 8 * fq, tl8 = (((wr * 4 + wc) * 64) + fq * 16 + fr) * 8;
        f32x4 bv[2][2];
#pragma unroll
        for (int bj = 0; bj < 2; ++bj)
#pragma unroll
            for (int n = 0; n < 2; ++n) bv[bj][n] = *(const f32x4*)(bmg + col0 + bj * HALF + 4 * n);
        EPI_ROWS( f32x4 v0 = (acc[ai][bj][m][0] + bv[bj][0]) * -1.4426950408889634f, v1 = (acc[ai][bj][m][1] + bv[bj][1]) * -1.4426950408889634f;
            _Pragma("unroll") for (int q = 0; q < 4; ++q) { v0[q] = __builtin_amdgcn_exp2f(v0[q]); v1[q] = __builtin_amdgcn_exp2f(v1[q]); }
            v0 = v0 + 1.0f; v1 = v1 + 1.0f;
            _Pragma("unroll") for (int q = 0; q < 4; ++q) { v0[q] = __builtin_amdgcn_rcpf(v0[q]); v1[q] = __builtin_amdgcn_rcpf(v1[q]); }
            *(u32x4*)(GT + (size_t)(u.pm * 16 + u.pn) * 65536 + ((ai * 4 + m) * 2 + bj) * 4096 + tl8) = pack8(v0, v1); )
    } };
template <bool ADD> struct EpiMix { static constexpr bool PERM = true; bf16_t* MIX; bf16_t* MIXA; const bf16_t* GT; int gt0;
    __device__ __forceinline__ void operator()(const f32x4 (&acc)[2][2][4][2], const Unit& u, int wr, int wc, int fr, int fq) const {
        const int col0 = u.pn * BM + wc * 32 + 8 * fq, tl8 = (((wr * 4 + wc) * 64) + fq * 16 + fr) * 8;
        const bf16_t* gt = GT + (size_t)(u.pm * 16 + u.pn + gt0) * 65536 + tl8; bf16_t* ma = MIXA + (size_t)(u.pm * 8 + u.pn) * 65536 + tl8;
        if constexpr (!ADD) {
            u32x4 gw[2][4][2];
#pragma unroll
            for (int ai = 0; ai < 2; ++ai)
#pragma unroll
                for (int m = 0; m < 4; ++m)
#pragma unroll
                    for (int bj = 0; bj < 2; ++bj) gw[ai][m][bj] = *(const u32x4*)(gt + ((ai * 4 + m) * 2 + bj) * 4096);
            EPI_ROWS( const int go = ((ai * 4 + m) * 2 + bj) * 4096; f32x4 g0, g1; unpack8(gw[ai][m][bj], g0, g1);
                *(u32x4*)(ma + go) = pack8(acc[ai][bj][m][0] * g0, acc[ai][bj][m][1] * g1); )
        } else {
#pragma unroll
            for (int ai = 0; ai < 2; ++ai) {
                u32x4 gw[4][2], pw[4][2];
#pragma unroll
                for (int m = 0; m < 4; ++m)
#pragma unroll
                    for (int bj = 0; bj < 2; ++bj) { const int go = ((ai * 4 + m) * 2 + bj) * 4096; gw[m][bj] = *(const u32x4*)(gt + go); pw[m][bj] = *(const u32x4*)(ma + go); }
#pragma unroll
                for (int m = 0; m < 4; ++m) { const int row = u.pm * BM + wr * 64 + fr + ai * HALF + m * 16;
#pragma unroll
                    for (int bj = 0; bj < 2; ++bj) { f32x4 g0, g1, p0, p1; unpack8(gw[m][bj], g0, g1); unpack8(pw[m][bj], p0, p1);
                        const f32x4 w0 = acc[ai][bj][m][0] * g0 + p0, w1 = acc[ai][bj][m][1] * g1 + p1;
                        if constexpr (kFp8Out) { v2u w; w.x = pk4_fp8(w0[0], w0[1], w0[2], w0[3]); w.y = pk4_fp8(w1[0], w1[1], w1[2], w1[3]); *(v2u*)((unsigned char*)MIX + (size_t)row * D + col0 + bj * HALF) = w; }
                        else *(u32x4*)(MIX + (size_t)row * D + col0 + bj * HALF) = pack8(w0, w1); } }
            }
        }
    } };
struct EpiX2 { static constexpr bool PERM = true; const float* X; bf16_t* X2;
    __device__ __forceinline__ void operator()(const f32x4 (&acc)[2][2][4][2], const Unit& u, int wr, int wc, int fr, int fq) const {
        const int col0 = u.pn * BM + wc * 32 + 8 * fq;
#pragma unroll
        for (int ai = 0; ai < 2; ++ai) {
            f32x4 xv[4][2][2];
#pragma unroll
            for (int m = 0; m < 4; ++m)
#pragma unroll
                for (int bj = 0; bj < 2; ++bj) { const size_t o = (size_t)(u.pm * BM + wr * 64 + fr + ai * HALF + m * 16) * D + col0 + bj * HALF; xv[m][bj][0] = *(const f32x4*)(X + o); xv[m][bj][1] = *(const f32x4*)(X + o + 4); }
#pragma unroll
            for (int m = 0; m < 4; ++m)
#pragma unroll
                for (int bj = 0; bj < 2; ++bj) { const size_t o = (size_t)(u.pm * BM + wr * 64 + fr + ai * HALF + m * 16) * D + col0 + bj * HALF;
                    *(u32x4*)(X2 + o) = pack8(xv[m][bj][0] + acc[ai][bj][m][0], xv[m][bj][1] + acc[ai][bj][m][1]); }
        }
    } };
template <bool OUT8> struct EpiMoeUp { static constexpr bool PERM = true; bf16_t* ACT; const PG8_LAS float* bias;
    __device__ __forceinline__ void operator()(const f32x4 (&acc)[2][2][4][2], const Unit& u, int wr, int wc, int fr, int fq) const {
        const int pnl = u.pn & 15, j0 = pnl * 128 + wc * 32 + 8 * fq;
        f32x4 bg[2], bu[2];
#pragma unroll
        for (int n = 0; n < 2; ++n) { bg[n] = *(const PG8_LAS f32x4*)(bias + u.ui * 256 + wc * 32 + 8 * fq + 4 * n); bu[n] = *(const PG8_LAS f32x4*)(bias + u.ui * 256 + 128 + wc * 32 + 8 * fq + 4 * n); }
#pragma unroll
        for (int ai = 0; ai < 2; ++ai)
#pragma unroll
            for (int m = 0; m < 4; ++m) { const int row = u.pm * BM + wr * 64 + fr + ai * HALF + m * 16; f32x4 o[2];
#pragma unroll
                for (int n = 0; n < 2; ++n) { f32x4 gt = acc[ai][0][m][n] + bg[n], up = acc[ai][1][m][n] + bu[n];
#pragma unroll
                    for (int q = 0; q < 4; ++q) { gt[q] = fminf(gt[q], 7.f); up[q] = fminf(fmaxf(up[q], -7.f), 7.f); }
                    f32x4 e = gt * (-1.702f * 1.4426950408889634f);
#pragma unroll
                    for (int q = 0; q < 4; ++q) e[q] = __builtin_amdgcn_exp2f(e[q]);
                    e = e + 1.0f;
#pragma unroll
                    for (int q = 0; q < 4; ++q) e[q] = __builtin_amdgcn_rcpf(e[q]);
                    o[n] = (up + 1.0f) * gt * e; }
                if constexpr (OUT8) { v2u w; w.x = pk4_fp8(o[0][0], o[0][1], o[0][2], o[0][3]); w.y = pk4_fp8(o[1][0], o[1][1], o[1][2], o[1][3]); *(v2u*)((unsigned char*)ACT + (size_t)row * DFF + j0) = w; }
                else *(u32x4*)(ACT + (size_t)row * DFF + j0) = pack8(o[0], o[1]); }
    } };
struct EpiMoeDn { static constexpr bool PERM = true; unsigned char* YM; const PG8_LAS float* bias;
    __device__ __forceinline__ void operator()(const f32x4 (&acc)[2][2][4][2], const Unit& u, int wr, int wc, int fr, int fq) const {
        const int pnl = u.pn & 7, col0 = pnl * BM + wc * 32 + 8 * fq;
        f32x4 bv[2][2];
#pragma unroll
        for (int bj = 0; bj < 2; ++bj)
#pragma unroll
            for (int n = 0; n < 2; ++n) bv[bj][n] = *(const PG8_LAS f32x4*)(bias + u.ui * 256 + bj * HALF + wc * 32 + 8 * fq + 4 * n);
        EPI_ROWS( const f32x4 v0 = (acc[ai][bj][m][0] + bv[bj][0]) * YM_SCALE, v1 = (acc[ai][bj][m][1] + bv[bj][1]) * YM_SCALE;
            v2u w; w.x = pk4_fp8(v0[0], v0[1], v0[2], v0[3]); w.y = pk4_fp8(v1[0], v1[1], v1[2], v1[3]);
            *(v2u*)(YM + (size_t)row * D + col0 + bj * HALF) = w; )
    } };
}

constexpr int NWAVES = 8;
#ifndef MK_N_LAUNCHES
#define MK_N_LAUNCHES 1
#endif
constexpr int PER_PHASE = 11;
#ifndef FP8_UP
#define FP8_UP 1
#endif
#ifndef FP8_DN
#define FP8_DN 1
#endif
constexpr bool kFp8Up = FP8_UP, kFp8Dn = FP8_DN;
constexpr float W8_SCALE = 64.f, W8_INV = 1.f / 64.f;
#ifndef NCONV
#define NCONV 64
#endif
constexpr int NCONV_WG = NCONV;
constexpr int N_LAUNCHES = MK_N_LAUNCHES;

constexpr size_t MiB = 1u << 20;
constexpr size_t WS_CTL = 0, CTL_ZERO_BYTES = 1 * MiB;
constexpr size_t WS_W1N = 1 * MiB;
constexpr size_t WS_WMG8 = WS_W1N + 16 * MiB;
constexpr size_t WS_W1V = WS_W1N + 32 * MiB;
constexpr size_t WS_WPA = WS_W1V + 8 * MiB;
constexpr size_t WS_WPB = WS_WPA + 4 * MiB;
constexpr size_t WS_WOT = WS_WPB + 4 * MiB;
constexpr size_t WS_WRH = WS_WOT + 8 * MiB;
constexpr size_t WS_WRL = WS_WRH + 128 * 1024;
constexpr size_t WS_WGU = WS_WRH + 1 * MiB;
constexpr size_t WS_WDN = WS_WGU + 512 * MiB;
constexpr size_t WS_H = WS_WDN + 256 * MiB;
constexpr size_t WS_AIF = WS_H + 64 * MiB;
constexpr size_t WS_QKO = WS_AIF + 1 * MiB;
constexpr size_t WS_GT = WS_QKO + 128 * MiB;
constexpr size_t WS_VT = WS_GT + 128 * MiB;
constexpr size_t WS_QC = WS_VT + 64 * MiB;
constexpr size_t WS_KC = WS_QC + 16 * MiB;
constexpr size_t WS_SC = WS_KC + 16 * MiB;
constexpr size_t SC_G = 4 * (size_t)M * 4, SC_MLOC = SC_G + 4096, SC_MPREV = SC_MLOC + 4096;
constexpr size_t WS_CLOC = WS_SC + 1 * MiB;
constexpr size_t WS_NLOC = WS_CLOC + 128 * MiB;
constexpr size_t WS_CPREV = WS_NLOC + 1 * MiB;
constexpr size_t WS_NPREV = WS_CPREV + 64 * MiB;
constexpr size_t WS_YA = WS_NPREV + 1 * MiB;
constexpr size_t WS_YB = WS_YA + 32 * MiB;
constexpr size_t WS_MIX = WS_YB + 32 * MiB;
constexpr size_t WS_X2 = WS_MIX + 64 * MiB;
constexpr size_t WS_H2 = WS_X2 + 128 * MiB;
constexpr size_t WS_H8 = WS_H2;
constexpr size_t WS_PE = WS_H2 + 64 * MiB;
constexpr size_t WS_PG = WS_PE + 256 * 1024;
constexpr size_t WS_LIST = WS_PG + 256 * 1024;
constexpr size_t WS_ACT = WS_LIST + 2 * MiB + 512 * 1024;
constexpr size_t WS_YM = WS_ACT + 288 * MiB;
constexpr size_t WS_END = WS_YM + 288 * MiB;
constexpr int CW_BAR = 4096;
constexpr int CW_Q = 12288;
constexpr int CW_CNT = 16384;

constexpr int RING_OFF = 0, RING_BYTES = 131072;
constexpr int TOK_OFF = RING_BYTES, MAX_UNITS = 18, TOK_BYTES = MAX_UNITS * 512;
constexpr int BIAS_OFF = TOK_OFF + TOK_BYTES, BIAS_BYTES = MAX_UNITS * 1024;
constexpr int UTAB_OFF = BIAS_OFF + BIAS_BYTES;
constexpr int TST_OFF = UTAB_OFF + 512;
constexpr int MISC_OFF = TST_OFF + 512;
constexpr int LDS_BYTES = MISC_OFF + 128;
static_assert(LDS_BYTES <= 163840, "LDS");

#define XB_TMO      128
#define XB_XCNT(j)  (256  + 64 * (j))
#define XB_XSUB(j)  (1280 + 64 * (j))
#define XB_XGEN(j)  (2304 + 64 * (j))
#define XB_TOP      3328
#define XB_TOPGEN   3392
#define XCD_BAR_WORDS 3456
#define XB_SPIN_CAP (1u << 22)
DI unsigned xb_ld(unsigned* p)              { return __hip_atomic_load(p, __ATOMIC_RELAXED, __HIP_MEMORY_SCOPE_AGENT); }
DI unsigned xb_add(unsigned* p, unsigned v) { return __hip_atomic_fetch_add(p, v, __ATOMIC_RELAXED, __HIP_MEMORY_SCOPE_AGENT); }
DI unsigned xb_xcc_id() { return (unsigned)__builtin_amdgcn_s_getreg((3 << 11) | 20) & 0xFu; }
#define XB_SPIN(cond, bar) do { unsigned _sp = 0; while (cond) { __builtin_amdgcn_s_sleep(1); \
    if ((++_sp & 255u) == 0u) { if (xb_ld(&(bar)[XB_TMO])) break; if (_sp > XB_SPIN_CAP) { atomicAdd(&(bar)[XB_TMO], 1u); break; } } } } while (0)
struct XcdBarrier { unsigned* bar; unsigned x; volatile LAS unsigned* st; };
DI XcdBarrier xcd_barrier_post(unsigned* bar, volatile LAS unsigned* st) {
    XcdBarrier b; b.bar = bar; b.x = xb_xcc_id(); b.st = st;
    if (threadIdx.x == 0) (void)xb_add(&bar[XB_XCNT(b.x)], 1u);
    return b;
}
DI void xcd_barrier_complete(unsigned* bar, unsigned x, unsigned& nloc, unsigned& nx) {
    const unsigned G = gridDim.x * gridDim.y * gridDim.z;
    unsigned sum, cnt, mine, sp = 0u;
    for (;;) {
        sum = 0u; cnt = 0u; mine = 0u;
#pragma unroll
        for (unsigned j = 0; j < 16; ++j) { const unsigned c = xb_ld(&bar[XB_XCNT(j)]); sum += c; cnt += (c > 0u) ? 1u : 0u; mine = (j == x) ? c : mine; }
        if (sum == G) break;
        __builtin_amdgcn_s_sleep(1);
        if ((++sp & 255u) == 0u) { if (xb_ld(&bar[XB_TMO])) break; if (sp > XB_SPIN_CAP) { atomicAdd(&bar[XB_TMO], 1u); break; } }
    }
    nloc = mine > 0u ? mine : 1u; nx = cnt > 0u ? cnt : 1u;
}
DI void xcd_barrier(const XcdBarrier& b) {
    asm volatile("s_waitcnt vmcnt(0)" ::: "memory");
    __syncthreads();
    if (threadIdx.x == 0) {
        unsigned* bar = b.bar;
        __builtin_amdgcn_s_waitcnt(0);
        unsigned nloc = b.st[0], nx = b.st[1];
        if (nloc == 0u) { xcd_barrier_complete(bar, b.x, nloc, nx); b.st[0] = nloc; b.st[1] = nx; }
        const unsigned old = xb_add(&bar[XB_XSUB(b.x)], 1u);
        const unsigned gen = old / nloc;
        if (old + 1u == (gen + 1u) * nloc) {
            __builtin_amdgcn_fence(__ATOMIC_RELEASE, "agent");
            asm volatile("s_waitcnt vmcnt(0)" ::: "memory");
            const unsigned og = xb_add(&bar[XB_TOP], 1u);
            const unsigned tg = og / nx;
            if (og + 1u == (tg + 1u) * nx) xb_add(&bar[XB_TOPGEN], 1u);
            else XB_SPIN(xb_ld(&bar[XB_TOPGEN]) == tg, bar);
            __builtin_amdgcn_fence(__ATOMIC_ACQUIRE, "agent");
            xb_add(&bar[XB_XGEN(b.x)], 1u);
            asm volatile("s_waitcnt vmcnt(0)" ::: "memory");
        } else {
            XB_SPIN(xb_ld(&bar[XB_XGEN(b.x)]) == gen, bar);
            __builtin_amdgcn_fence(__ATOMIC_ACQUIRE, "agent");
            asm volatile("s_waitcnt vmcnt(0)" ::: "memory");
        }
    }
    __syncthreads();
}

struct Frame {
    LAS unsigned char* lds;
    unsigned char* ws;
    gu32* ctl;
    int tid, lane, wave, G, bx;
    const float *x, *norm_mix, *w_in, *conv_w, *conv_b, *b_if, *norm_head, *w_pa, *w_pb, *w_mg, *b_mg, *w_out, *norm_ffn, *w_r, *b_r, *w_gu, *b_gu, *w_dn, *b_dn, *norm_final;
    float* out;
};
#define WSP(T, off) ((T*)(F.ws + (off)))

template <bool F8> DI void tr_item(const float* W, size_t pitch, size_t col0, int k0, void* WT, size_t drow0, int Kd, LAS unsigned char* scr, int lane) {
    constexpr int RB = F8 ? 128 : 256, PB = RB + 16;
    const int n4 = lane & 7, kr = lane >> 3;
    f32x4 v[16];
#pragma unroll
    for (int i = 0; i < 16; ++i) v[i] = __builtin_nontemporal_load((const GAS f32x4*)(W + (size_t)(k0 + 16 * kr + i) * pitch + col0 + 4 * n4));
#pragma unroll
    for (int q = 0; q < 4; ++q) { LAS unsigned char* rowp = scr + (q * 8 + n4) * PB + kr * (F8 ? 16 : 32);
        if constexpr (F8) { v4u o; o.x = pk4_fp8(v[0][q] * W8_SCALE, v[1][q] * W8_SCALE, v[2][q] * W8_SCALE, v[3][q] * W8_SCALE); o.y = pk4_fp8(v[4][q] * W8_SCALE, v[5][q] * W8_SCALE, v[6][q] * W8_SCALE, v[7][q] * W8_SCALE);
            o.z = pk4_fp8(v[8][q] * W8_SCALE, v[9][q] * W8_SCALE, v[10][q] * W8_SCALE, v[11][q] * W8_SCALE); o.w = pk4_fp8(v[12][q] * W8_SCALE, v[13][q] * W8_SCALE, v[14][q] * W8_SCALE, v[15][q] * W8_SCALE);
            *(LAS v4u*)rowp = o; }
        else { v4u o0, o1; o0.x = cvtpk(v[0][q], v[1][q]); o0.y = cvtpk(v[2][q], v[3][q]); o0.z = cvtpk(v[4][q], v[5][q]); o0.w = cvtpk(v[6][q], v[7][q]);
            o1.x = cvtpk(v[8][q], v[9][q]); o1.y = cvtpk(v[10][q], v[11][q]); o1.z = cvtpk(v[12][q], v[13][q]); o1.w = cvtpk(v[14][q], v[15][q]);
            *(LAS v4u*)rowp = o0; *(LAS v4u*)(rowp + 16) = o1; } }
    LDS_WAIT(); asm volatile("" ::: "memory");
    constexpr int CPR = RB / 16;
#pragma unroll
    for (int jj = 0; jj < (32 * CPR) / 64; ++jj) { const int idx = lane + 64 * jj, rho = idx / CPR, ch = idx % CPR, n = 4 * (rho & 7) + (rho >> 3);
        const v4u o = *(const LAS v4u*)(scr + rho * PB + 16 * ch);
        __builtin_nontemporal_store(o, (GAS v4u*)((unsigned char*)WT + ((drow0 + n) * (size_t)Kd + k0) * (F8 ? 1 : 2) + 16 * ch)); }
    LDS_WAIT(); asm volatile("" ::: "memory");
}
DI void p0_prologue(Frame& F) {
    LAS unsigned char* scr = F.lds + RING_OFF + F.wave * 8704;
    const int gw = F.bx * NWAVES + F.wave, NGW = F.G * NWAVES;
    bf16* W1N = WSP(bf16, WS_W1N); bf16* W1V = WSP(bf16, WS_W1V);
    constexpr int KB = D / 128;
    constexpr int I0 = KB * 32, I1 = KB * 32, I2 = KB * 64, I3 = KB * 128, I4 = KB * 32, I5 = KB * 32, I6 = 8 * 64, I7 = 8 * 64, I8 = KB * 64;
    constexpr int NSMALL = I0 + I1 + I2 + I3 + I4 + I5 + I6 + I7 + I8;
    for (int it = gw; it < NSMALL; it += NGW) {
        const float* W; size_t pitch, scol, drow; int ncols, K; bf16* WT; int r = it; bool f8 = false;
        if (r < I0) { W = F.w_in; pitch = INC; scol = 0; ncols = 1024; K = D; WT = W1N; drow = 0; }
        else if ((r -= I0) < I1) { W = F.w_in; pitch = INC; scol = 2048; ncols = 1024; K = D; WT = W1N; drow = 1024; }
        else if ((r -= I1) < I2) { W = F.w_in; pitch = INC; scol = 3080; ncols = 2048; K = D; WT = W1N; drow = 2048; }
        else if ((r -= I2) < I3) { f8 = true; W = F.w_mg; pitch = 4096; scol = 0; ncols = 4096; K = D; WT = WSP(bf16, WS_WMG8); drow = 0; }
        else if ((r -= I3) < I4) { W = F.w_in; pitch = INC; scol = 1024; ncols = 1024; K = D; WT = W1V; drow = 0; }
        else if ((r -= I4) < I5) { W = F.w_in; pitch = INC; scol = 5128; ncols = 1024; K = D; WT = W1V; drow = 1024; }
        else if ((r -= I5) < I6) { W = F.w_pa; pitch = D; scol = 0; ncols = 2048; K = 1024; WT = WSP(bf16, WS_WPA); drow = 0; }
        else if ((r -= I6) < I7) { W = F.w_pb; pitch = D; scol = 0; ncols = 2048; K = 1024; WT = WSP(bf16, WS_WPB); drow = 0; }
        else { r -= I7; f8 = kFp8Out; W = F.w_out; pitch = D; scol = 0; ncols = 2048; K = D; WT = WSP(bf16, WS_WOT); drow = 0; }
        const int nbl = ncols / 32, kb = r / nbl, nb = r % nbl, n0 = 32 * nb;
        if (f8) tr_item<true>(W, pitch, scol + n0, 128 * kb, WT, drow + n0, K, scr, F.lane); else tr_item<false>(W, pitch, scol + n0, 128 * kb, WT, drow + n0, K, scr, F.lane);
    }
    for (int i = (F.bx * 512 + F.tid); i < NE * D; i += F.G * 512) { const int e = i / D, k = i % D; const float w = F.norm_ffn[k] * F.w_r[k * NE + e];
        const bf16 hi = f2bf(w); WSP(bf16, WS_WRH)[i] = hi; WSP(bf16, WS_WRL)[i] = f2bf(w - bf2f(hi)); }
    __syncthreads();
    LAS float* wif = (LAS float*)(F.lds + RING_OFF);
#pragma unroll
    for (int ii = 0; ii < 8 * D / 512; ++ii) { const int i = F.tid + 512 * ii, k = i >> 3, j = i & 7; wif[j * D + k] = F.w_in[(size_t)k * INC + 3072 + j]; }
    __syncthreads();
    bf16* H = WSP(bf16, WS_H); float* AIF = WSP(float, WS_AIF);
    f32x4 g[8], vn[8];
    { const GAS f32x4* gr = (const GAS f32x4*)F.norm_mix + F.lane;
#pragma unroll
      for (int j = 0; j < 8; ++j) g[j] = gr[64 * j];
      const GAS f32x4* xr = (const GAS f32x4*)(F.x + (size_t)(gw < M ? gw : 0) * D) + F.lane;
#pragma unroll
      for (int j = 0; j < 8; ++j) vn[j] = xr[64 * j]; }
    for (int m = gw; m < M; m += NGW) {
        f32x4 v[8]; float ss = 0.f;
#pragma unroll
        for (int j = 0; j < 8; ++j) { v[j] = vn[j]; ss += (v[j].x * v[j].x + v[j].y * v[j].y) + (v[j].z * v[j].z + v[j].w * v[j].w); }
        { const int mn = (m + NGW < M) ? m + NGW : m; const GAS f32x4* xr = (const GAS f32x4*)(F.x + (size_t)mn * D) + F.lane;
#pragma unroll
          for (int j = 0; j < 8; ++j) vn[j] = xr[64 * j]; }
        const float rstd = 1.f / sqrtf(wave_sum(ss) * (1.f / D) + EPS);
        GAS v2u* o8 = (GAS v2u*)(H + (size_t)m * D) + F.lane; GAS unsigned* o4 = (GAS unsigned*)(F.ws + WS_H8 + (size_t)m * D) + F.lane;
#pragma unroll
        for (int j = 0; j < 8; ++j) { v[j] = v[j] * rstd * g[j]; v2u w; w.x = cvtpk(v[j].x, v[j].y); w.y = cvtpk(v[j].z, v[j].w); o8[64 * j] = w; o4[64 * j] = pk4_fp8(v[j].x, v[j].y, v[j].z, v[j].w); }
        float p[8];
#pragma unroll
        for (int q = 0; q < 8; ++q) { float a = 0.f;
#pragma unroll
            for (int j = 0; j < 8; ++j) { const f32x4 w = *(const LAS f32x4*)(wif + q * D + 4 * F.lane + 256 * j); a += (v[j].x * w.x + v[j].y * w.y) + (v[j].z * w.z + v[j].w * w.w); }
            p[q] = a; asm volatile("" ::: "memory"); }
        const bool b5 = (F.lane & 32) != 0, b4 = (F.lane & 16) != 0, b3 = (F.lane & 8) != 0;
        float r4[4], r2[2], r1;
#pragma unroll
        for (int i = 0; i < 4; ++i) { const float snd = b5 ? p[i] : p[i + 4], kp = b5 ? p[i + 4] : p[i]; r4[i] = kp + __shfl_xor(snd, 32); }
#pragma unroll
        for (int i = 0; i < 2; ++i) { const float snd = b4 ? r4[i] : r4[i + 2], kp = b4 ? r4[i + 2] : r4[i]; r2[i] = kp + __shfl_xor(snd, 16); }
        { const float snd = b3 ? r2[0] : r2[1], kp = b3 ? r2[1] : r2[0]; r1 = kp + __shfl_xor(snd, 8); }
        r1 += __shfl_xor(r1, 4); r1 += __shfl_xor(r1, 2); r1 += __shfl_xor(r1, 1);
        { const int q = (F.lane >> 3) & 7; const int qq = ((q & 4) ? 4 : 0) + ((q & 2) ? 2 : 0) + (q & 1);
          if ((F.lane & 7) == 0) AIF[(size_t)m * 8 + qq] = r1 + F.b_if[qq]; }
    }
}

constexpr int CONV_BATCH = 8;
DI void conv_queue(Frame& F) {
    LAS unsigned char* scr = F.lds + RING_OFF + F.wave * 8704;
    constexpr int KB = D / 128, IGU = KB * 128, IDN = KB * 64, IEX = IGU + IDN, NITEMS = NE * IEX;
    for (;;) {
        int base = 0; if (F.lane == 0) base = (int)__hip_atomic_fetch_add((unsigned*)(F.ctl + CW_Q), (unsigned)CONV_BATCH, RLX_AGENT);
        base = __builtin_amdgcn_readfirstlane(base);
        if (base >= NITEMS) break;
        for (int it = base; it < base + CONV_BATCH && it < NITEMS; ++it) {
            const int e = it / IEX; int r = it % IEX;
            if (r < IGU) { const int kb = r / 128, nb = r % 128, n0 = 32 * nb, np = n0 & 2047; const size_t dr = (size_t)(np / 128) * 256 + (n0 >= 2048 ? 128 : 0) + (np % 128);
                if (kFp8Up) tr_item<true>(F.w_gu + (size_t)e * D * 4096, 4096, n0, 128 * kb, F.ws + WS_WGU + (size_t)e * 4096 * D, dr, D, scr, F.lane);
                else tr_item<false>(F.w_gu + (size_t)e * D * 4096, 4096, n0, 128 * kb, F.ws + WS_WGU + (size_t)e * 4096 * D * 2, dr, D, scr, F.lane); }
            else { r -= IGU; const int kb = r / 64, nb = r % 64, n0 = 32 * nb;
                if (kFp8Dn) tr_item<true>(F.w_dn + (size_t)e * DFF * D, D, n0, 128 * kb, F.ws + WS_WDN + (size_t)e * D * DFF, n0, DFF, scr, F.lane);
                else tr_item<false>(F.w_dn + (size_t)e * DFF * D, D, n0, 128 * kb, F.ws + WS_WDN + (size_t)e * D * DFF * 2, n0, DFF, scr, F.lane); }
        }
    }
}

struct AttnCtx { const bf16* ksrc; const bf16* vsrc; LAS unsigned char* vimg; LAS unsigned char* qimg; int n, h, vr_, vc_; float CS; };
template <bool DIAG> DI void attn_block(const AttnCtx& A, int kn, const bf16x8 (&akc)[8], bf16x8 (&akn)[8], v4u (&vreg)[8], f32x16 (&o)[4], float& carry) {
    const int n = A.n, h = A.h;
#pragma unroll
    for (int i = 0; i < 8; ++i) *(LAS v4u*)(A.vimg + (A.vr_ + 16 * i) * 80 + 16 * A.vc_) = vreg[i];
#pragma unroll
    for (int i = 0; i < 8; ++i) vreg[i] = *(const GAS v4u*)(A.vsrc + (size_t)kn * 4096 + 512 * i);
    { const bf16* krow = A.ksrc + (size_t)(32 * kn) * 4096;
#pragma unroll
      for (int s = 0; s < 8; ++s) akn[s] = *(const GAS bf16x8*)(krow + 16 * s); }
    __builtin_amdgcn_sched_barrier(0);
    f32x16 sc; bf16x8 bqs[8];
#pragma unroll
    for (int r = 0; r < 16; ++r) sc[r] = 0.f;
#pragma unroll
    for (int s = 0; s < 8; ++s) bqs[s] = *(const LAS bf16x8*)(A.qimg + n * 272 + 32 * s + 16 * h);
    __builtin_amdgcn_sched_barrier(0);
#pragma unroll
    for (int s = 0; s < 8; ++s) sc = MFMA32(akc[s], bqs[s], sc);
    float bt[16], kp[16];
#pragma unroll
    for (int r = 0; r < 16; ++r) { const float z = sc[r] * A.CS, e = __builtin_amdgcn_exp2f(-fabsf(z)), d = __builtin_amdgcn_rcpf(1.f + e), ed = e * d;
        float b_ = z >= 0.f ? d : ed, k_ = z >= 0.f ? ed : d;
        if (DIAG && !(crow(r, h) < n)) { b_ = 0.f; k_ = 1.f; }
        bt[r] = b_; kp[r] = k_; }
    float Gs[4], Go[4], T[4];
#pragma unroll
    for (int g = 0; g < 4; ++g) { Gs[g] = (kp[4 * g] * kp[4 * g + 1]) * (kp[4 * g + 2] * kp[4 * g + 3]); Go[g] = __shfl_xor(Gs[g], 32); T[g] = Gs[g] * Go[g]; }
    float tail[4]; tail[3] = 1.f; tail[2] = T[3]; tail[1] = T[3] * T[2]; tail[0] = tail[1] * T[1];
    float att[16];
#pragma unroll
    for (int g = 0; g < 4; ++g) { float R = carry * tail[g] * (h == 0 ? Go[g] : 1.f);
#pragma unroll
        for (int i = 3; i >= 0; --i) { att[4 * g + i] = bt[4 * g + i] * R; R *= kp[4 * g + i]; } }
    carry *= tail[0] * T[0];
    bf16x4 vlo[4][2], vhi[4][2];
#pragma unroll
    for (int dt = 0; dt < 4; ++dt)
#pragma unroll
        for (int s = 0; s < 2; ++s) { const LAS unsigned char* vp = A.vimg + (32 * dt + n) * 80 + 32 * s + 8 * h;
            vlo[dt][s] = *(const LAS bf16x4*)vp; vhi[dt][s] = *(const LAS bf16x4*)(vp + 16); }
    __builtin_amdgcn_sched_barrier(0);
    bf16x8 pf[2];
#pragma unroll
    for (int s = 0; s < 2; ++s) { v4u w; w.x = cvtpk(att[8 * s], att[8 * s + 1]); w.y = cvtpk(att[8 * s + 2], att[8 * s + 3]); w.z = cvtpk(att[8 * s + 4], att[8 * s + 5]); w.w = cvtpk(att[8 * s + 6], att[8 * s + 7]);
        pf[s] = __builtin_bit_cast(bf16x8, w); }
#pragma unroll
    for (int dt = 0; dt < 4; ++dt)
#pragma unroll
        for (int s = 0; s < 2; ++s) { const bf16x8 av = __builtin_shufflevector(vlo[dt][s], vhi[dt][s], 0, 1, 2, 3, 4, 5, 6, 7);
            o[dt] = MFMA32(av, pf[s], o[dt]); }
}
DI void attn_wave_unit(const bf16* QKO, const bf16* VT, bf16* YB, int hd, int qt, int lane, LAS unsigned char* vimg) {
    const int n = lane & 31, h = lane >> 5, t0 = 32 * qt;
    AttnCtx A; A.n = n; A.h = h; A.vr_ = lane >> 2; A.vc_ = lane & 3; A.vimg = vimg; A.qimg = vimg + 10240;
    A.CS = 0.08838834764831845f * 1.4426950408889634f;
    A.vsrc = VT + VT_B + (size_t)hd * 512 * 4096 + A.vr_ * 32 + 8 * A.vc_;
    A.ksrc = QKO + (size_t)n * 4096 + 3072 + hd * 128 + 8 * h;
    { const bf16* qrow = QKO + (size_t)(t0 + n) * 4096 + 2048 + hd * 128 + 8 * h;
#pragma unroll
      for (int s = 0; s < 8; ++s) *(LAS bf16x8*)(A.qimg + n * 272 + 32 * s + 16 * h) = *(const GAS bf16x8*)(qrow + 16 * s); }
    f32x16 o[4];
#pragma unroll
    for (int d = 0; d < 4; ++d)
#pragma unroll
        for (int r = 0; r < 16; ++r) o[d][r] = 0.f;
    float carry = 1.f;
    bf16x8 akA[8], akB[8]; v4u vreg[8];
    { const bf16* krow = A.ksrc + (size_t)(32 * qt) * 4096;
#pragma unroll
      for (int s = 0; s < 8; ++s) akA[s] = *(const GAS bf16x8*)(krow + 16 * s);
#pragma unroll
      for (int i = 0; i < 8; ++i) vreg[i] = *(const GAS v4u*)(A.vsrc + (size_t)qt * 4096 + 512 * i); }
    int kb = qt;
    attn_block<true>(A, kb > 0 ? kb - 1 : 0, akA, akB, vreg, o, carry);
    while (kb > 0 && !__all(carry == 0.f)) {
        --kb; attn_block<false>(A, kb > 0 ? kb - 1 : 0, akB, akA, vreg, o, carry);
        if (kb == 0 || __all(carry == 0.f)) break;
        --kb; attn_block<false>(A, kb > 0 ? kb - 1 : 0, akA, akB, vreg, o, carry);
    }
    bf16* yrow = YB + (size_t)(t0 + n) * 1024 + hd * 128 + 4 * h;
#pragma unroll
    for (int dt = 0; dt < 4; ++dt)
#pragma unroll
        for (int g = 0; g < 4; ++g) { v2u w; w.x = cvtpk(o[dt][4 * g], o[dt][4 * g + 1]); w.y = cvtpk(o[dt][4 * g + 2], o[dt][4 * g + 3]); *(GAS v2u*)(yrow + 32 * dt + 8 * g) = w; }
}

DI void mlstm_a_unit(Frame& F, int hd, int c) {
    LAS float* sE = (LAS float*)(F.lds + RING_OFF);
    LAS float* sCW = (LAS float*)(F.lds + RING_OFF + 256);
    LAS bf16* sKeT = (LAS bf16*)(F.lds + RING_OFF + 8192);
    const int t0 = CH * c;
    const bf16* QKO = WSP(const bf16, WS_QKO); const float* AIF = WSP(const float, WS_AIF); const bf16* VT = WSP(const bf16, WS_VT);
    float* ACUM = WSP(float, WS_SC); float* GG = (float*)(F.ws + WS_SC + SC_G); float* MLOC = (float*)(F.ws + WS_SC + SC_MLOC);
    const int t = F.tid >> 3, cg = F.tid & 7, n = F.lane & 31, h = F.lane >> 5, w = F.wave;
    v4u cin[2][4][2];
#pragma unroll
    for (int which = 0; which < 2; ++which)
#pragma unroll
        for (int j = 0; j < 4; ++j) { const int tt = t0 + t - 3 + j; const bf16* rp = QKO + (size_t)(tt < 0 ? 0 : tt) * 4096 + which * 512 + hd * 128 + 16 * cg;
            v4u a = *(const GAS v4u*)rp, b = *(const GAS v4u*)(rp + 8);
            if (tt < 0) { a = (v4u){0u, 0u, 0u, 0u}; b = a; }
            cin[which][j][0] = a; cin[which][j][1] = b; }
    bf16x8 bv[4];
#pragma unroll
    for (int s = 0; s < 4; ++s) bv[s] = *(const GAS bf16x8*)(VT + ((((size_t)(hd * NCH + c) * 256 + 32 * w + n)) << 6) + 16 * s + 8 * h);
    {   float cwv[3];
#pragma unroll
        for (int q = 0; q < 3; ++q) { const int i = F.tid + 512 * q, j = (i >> 8) < 4 ? (i >> 8) : 4, cc = i & 255; const int gcol = (cc < 128) ? hd * 128 + cc : 512 + hd * 128 + (cc - 128);
            cwv[q] = (j < 4) ? F.conv_w[j * 1024 + gcol] : F.conv_b[gcol]; }
#pragma unroll
        for (int q = 0; q < 3; ++q) { const int i = F.tid + 512 * q; if (i < 5 * 256) sCW[i] = cwv[q]; } }
    if (F.wave == 0) {
        const int tl = F.lane; const float f = AIF[(size_t)(t0 + tl) * 8 + 4 + hd], ig = AIF[(size_t)(t0 + tl) * 8 + hd];
        float a = fminf(f, 0.f) - log1pf(__expf(-fabsf(f)));
#pragma unroll
        for (int o = 1; o < 64; o <<= 1) { const float v = __shfl_up(a, o); if (tl >= o) a += v; }
        const float g = __shfl(a, 63), wv = g - a + ig, ml = wave_max(wv);
        sE[tl] = __expf(wv - ml); ACUM[(size_t)hd * M + t0 + tl] = a;
        if (tl == 0) { GG[hd * NCH + c] = g; MLOC[hd * NCH + c] = ml; }
    }
    __syncthreads();
    {
        const float et = sE[t];
#pragma unroll
        for (int which = 0; which < 2; ++which) {
            float acc[16];
#pragma unroll
            for (int i = 0; i < 16; ++i) acc[i] = sCW[4 * 256 + which * 128 + 16 * cg + i];
#pragma unroll
            for (int j = 0; j < 4; ++j) { const v4u a = cin[which][j][0], b = cin[which][j][1];
                const unsigned ww[8] = {a.x, a.y, a.z, a.w, b.x, b.y, b.z, b.w};
#pragma unroll
                for (int i = 0; i < 8; ++i) { acc[2 * i] += sCW[j * 256 + which * 128 + 16 * cg + 2 * i] * bflo(ww[i]); acc[2 * i + 1] += sCW[j * 256 + which * 128 + 16 * cg + 2 * i + 1] * bfhi(ww[i]); } }
#pragma unroll
            for (int i = 0; i < 16; ++i) { acc[i] = acc[i] * sigmoidf_(acc[i]); if (which) acc[i] *= 0.08838834764831845f; }
            bf16* op = WSP(bf16, which ? WS_KC : WS_QC) + (size_t)(t0 + t) * 512 + hd * 128 + 16 * cg;
            v4u o0, o1; o0.x = cvtpk(acc[0], acc[1]); o0.y = cvtpk(acc[2], acc[3]); o0.z = cvtpk(acc[4], acc[5]); o0.w = cvtpk(acc[6], acc[7]);
            o1.x = cvtpk(acc[8], acc[9]); o1.y = cvtpk(acc[10], acc[11]); o1.z = cvtpk(acc[12], acc[13]); o1.w = cvtpk(acc[14], acc[15]);
            *(GAS v4u*)op = o0; *(GAS v4u*)(op + 8) = o1;
            if (which) {
#pragma unroll
                for (int i = 0; i < 16; ++i) sKeT[(16 * cg + i) * 72 + t] = f2bf(et * acc[i]); }
        }
    }
    __syncthreads();
    {
        bf16* cl = WSP(bf16, WS_CLOC) + (((size_t)(hd * 64 + ((32 * w + n) >> 2)) * NCH + c) * 512 + (n & 3) * 128);
        bf16x8 ka_[4][4];
#pragma unroll
        for (int kt = 0; kt < 4; ++kt)
#pragma unroll
            for (int s2 = 0; s2 < 4; ++s2) ka_[kt][s2] = *(const LAS bf16x8*)(sKeT + (32 * kt + n) * 72 + 16 * s2 + 8 * h);
        __builtin_amdgcn_sched_barrier(0);
#pragma unroll
        for (int kt = 0; kt < 4; ++kt) { f32x16 acc;
#pragma unroll
            for (int r = 0; r < 16; ++r) acc[r] = 0.f;
#pragma unroll
            for (int s2 = 0; s2 < 4; ++s2) acc = MFMA32(ka_[kt][s2], bv[s2], acc);
#pragma unroll
            for (int g = 0; g < 4; ++g) { v2u o; o.x = cvtpk(acc[4 * g], acc[4 * g + 1]); o.y = cvtpk(acc[4 * g + 2], acc[4 * g + 3]); *(GAS v2u*)(cl + 32 * kt + 8 * g + 4 * h) = o; } }
        if (F.tid < 128) { float sm = 0.f;
#pragma unroll
            for (int t8 = 0; t8 < 8; ++t8) { const v4u q = *(const LAS v4u*)(sKeT + F.tid * 72 + 8 * t8); sm += (bflo(q.x) + bfhi(q.x)) + (bflo(q.y) + bfhi(q.y)) + (bflo(q.z) + bfhi(q.z)) + (bflo(q.w) + bfhi(q.w)); }
            WSP(float, WS_NLOC)[(size_t)(hd * NCH + c) * 128 + F.tid] = sm; }
    }
    __syncthreads();
}

DI void mlstm_scan(Frame& F) {
    LAS float* sG = (LAS float*)(F.lds + RING_OFF); LAS float* sML = sG + 256; LAS float* sSo = sG + 512; LAS float* sSn = sG + 768;
    const float* GG = (const float*)(F.ws + WS_SC + SC_G); const float* MLOC = (const float*)(F.ws + WS_SC + SC_MLOC); float* MPREV = (float*)(F.ws + WS_SC + SC_MPREV);
    for (int hb = F.bx; hb < 256; hb += F.G) {
        const int hd = hb >> 6, part = hb & 63;
        if (F.tid < 256) { sG[F.tid] = GG[hd * NCH + F.tid]; sML[F.tid] = MLOC[hd * NCH + F.tid]; }
        __syncthreads();
        if (F.wave == 0) { const int l = F.lane; float ga[4], mla[4];
#pragma unroll
            for (int q = 0; q < 4; ++q) { ga[q] = sG[4 * l + q]; mla[q] = sML[4 * l + q]; }
            float A = ga[0], B = mla[0];
#pragma unroll
            for (int q = 1; q < 4; ++q) { B = fmaxf(B + ga[q], mla[q]); A += ga[q]; }
#pragma unroll
            for (int o = 1; o < 64; o <<= 1) { const float Ap = __shfl_up(A, o), Bp = __shfl_up(B, o); if (l >= o) { B = fmaxf(Bp + A, B); A = Ap + A; } }
            const float Ae = __shfl_up(A, 1), Be = __shfl_up(B, 1);
            float m = (l == 0) ? 0.f : fmaxf(Ae, Be);
#pragma unroll
            for (int q = 0; q < 4; ++q) { const int c = 4 * l + q; const float mn = fmaxf(ga[q] + m, mla[q]); sSo[c] = __expf(ga[q] + m - mn); sSn[c] = __expf(mla[q] - mn); if (part == 0) MPREV[hd * NCH + c] = m; m = mn; } }
        __syncthreads();
        if (F.tid < 128) {
            const bf16* cl = WSP(const bf16, WS_CLOC) + (size_t)(hd * 64 + part) * NCH * 512 + 4 * F.tid; bf16* cp = WSP(bf16, WS_CPREV) + (size_t)(hd * 64 + part) * NCH * 512 + 4 * F.tid;
            f32x4 C = {0.f, 0.f, 0.f, 0.f};
            for (int c0 = 0; c0 < NCH; c0 += 16) { v2u v[16];
#pragma unroll
                for (int i = 0; i < 16; ++i) v[i] = *(const GAS v2u*)(cl + (size_t)(c0 + i) * 512);
#pragma unroll
                for (int i = 0; i < 16; ++i) { v2u wq; wq.x = cvtpk(C.x, C.y); wq.y = cvtpk(C.z, C.w); *(GAS v2u*)(cp + (size_t)(c0 + i) * 512) = wq;
                    const f32x4 vf = {bflo(v[i].x), bfhi(v[i].x), bflo(v[i].y), bfhi(v[i].y)}; C = C * sSo[c0 + i] + vf * sSn[c0 + i]; } }
        } else if (F.tid < 256 && part == 0) {
            const int k = F.tid - 128; float N = 0.f; const float* nl = WSP(const float, WS_NLOC) + (size_t)hd * NCH * 128 + k; float* np = WSP(float, WS_NPREV) + (size_t)hd * NCH * 128 + k;
            for (int c0 = 0; c0 < NCH; c0 += 32) { float nv[32];
#pragma unroll
                for (int i = 0; i < 32; ++i) nv[i] = nl[(size_t)(c0 + i) * 128];
#pragma unroll
                for (int i = 0; i < 32; ++i) { np[(size_t)(c0 + i) * 128] = N; N = N * sSo[c0 + i] + nv[i] * sSn[c0 + i]; } }
        }
        __syncthreads();
    }
}

DI void mlstm_c_unit(Frame& F, int hd, int c) {
    LAS float* sB = (LAS float*)(F.lds + RING_OFF);
    LAS float* sMx = sB + 64; LAS float* sSi = sB + 128; LAS float* sEmt = sB + 192; LAS float* sQN = sB + 256;
    LAS float* sRS = sB + 320;
    LAS float* sSS = sB + 448;
    LAS bf16* sQs = (LAS bf16*)(F.lds + RING_OFF + 4096);
    LAS bf16* sP = (LAS bf16*)(F.lds + RING_OFF + 4096 + 64 * 136 * 2);
    const int t0 = CH * c, n = F.lane & 31, h = F.lane >> 5, w = F.wave;
    const bf16* QC = WSP(const bf16, WS_QC); const bf16* KC = WSP(const bf16, WS_KC); const bf16* VT = WSP(const bf16, WS_VT); const float* AIF = WSP(const float, WS_AIF);
    const float* ACUM = WSP(const float, WS_SC); const float* MPREV = (const float*)(F.ws + WS_SC + SC_MPREV);
    const bf16* QKO = WSP(const bf16, WS_QKO); bf16* YA = WSP(bf16, WS_YA);
    const float mprev = MPREV[hd * NCH + c];
    bf16x8 ac[8], av[4];
    { const bf16* cp = WSP(const bf16, WS_CPREV) + (((size_t)(hd * 64 + ((32 * w + n) >> 2)) * NCH + c) * 512 + (n & 3) * 128) + 8 * h; const bf16* vr = VT + ((((size_t)(hd * NCH + c) * 256 + 32 * w + n)) << 6) + 8 * h;
#pragma unroll
      for (int s = 0; s < 8; ++s) ac[s] = *(const GAS bf16x8*)(cp + 16 * s);
#pragma unroll
      for (int s = 0; s < 4; ++s) av[s] = *(const GAS bf16x8*)(vr + 16 * s); }
    v2u ow[2][4]; f32x4 nh[4];
#pragma unroll
    for (int g = 0; g < 4; ++g) { const int v0 = hd * 256 + 32 * w + 8 * g + 4 * h; nh[g] = *(const GAS f32x4*)(F.norm_head + v0);
#pragma unroll
        for (int tt = 0; tt < 2; ++tt) ow[tt][g] = *(const GAS v2u*)(QKO + (size_t)(t0 + 32 * tt + n) * 4096 + 1024 + v0); }
    const int si = w >> 1, ti = w & 1;
    bf16x8 ka[8], qb[8];
    v4u qch[4]; f32x4 npv[8];
    float ga = 0.f, gi = 0.f;
    if (w < 4) {
        if (si <= ti) { const bf16* kr = KC + (size_t)(t0 + 32 * si + n) * 512 + hd * 128 + 8 * h; const bf16* qr = QC + (size_t)(t0 + 32 * ti + n) * 512 + hd * 128 + 8 * h;
#pragma unroll
            for (int s = 0; s < 8; ++s) { ka[s] = *(const GAS bf16x8*)(kr + 16 * s); qb[s] = *(const GAS bf16x8*)(qr + 16 * s); } }
    } else {
        const int u = F.tid - 256, t = u >> 2, qd = u & 3;
        const bf16* qr = QC + (size_t)(t0 + t) * 512 + hd * 128 + 32 * qd; const float* np = WSP(const float, WS_NPREV) + (size_t)(hd * NCH + c) * 128 + 32 * qd;
#pragma unroll
        for (int j = 0; j < 4; ++j) { qch[j] = *(const GAS v4u*)(qr + 8 * j); npv[2 * j] = *(const GAS f32x4*)(np + 8 * j); npv[2 * j + 1] = *(const GAS f32x4*)(np + 8 * j + 4); }
        if (w == 4) { ga = ACUM[(size_t)hd * M + t0 + F.lane]; gi = AIF[(size_t)(t0 + F.lane) * 8 + hd]; }
    }
    if (w == 4) {
        const int t = F.lane; const float bq_ = gi - ga;
        float pm = bq_;
#pragma unroll
        for (int o = 1; o < 64; o <<= 1) { const float v = __shfl_up(pm, o); if (t >= o) pm = fmaxf(pm, v); }
        const float mx = fmaxf(mprev, pm);
        sB[t] = bq_; sMx[t] = mx; sSi[t] = __expf(mprev - mx); sEmt[t] = __expf(-ga - mx);
    }
    __syncthreads();
    if (w < 4) {
        f32x16 acc;
#pragma unroll
        for (int r = 0; r < 16; ++r) acc[r] = 0.f;
        if (si <= ti) {
#pragma unroll
            for (int s = 0; s < 8; ++s) acc = MFMA32(ka[s], qb[s], acc);
        }
        const int t = 32 * ti + n; const float mx = sMx[t]; float rs = 0.f;
#pragma unroll
        for (int g = 0; g < 4; ++g) { float p[4];
#pragma unroll
            for (int i = 0; i < 4; ++i) { const int sI = 32 * si + 8 * g + 4 * h + i; p[i] = (sI <= t) ? __expf(sB[sI] - mx) * acc[4 * g + i] : 0.f; rs += p[i]; }
            v2u wv; wv.x = cvtpk(p[0], p[1]); wv.y = cvtpk(p[2], p[3]); *(LAS v2u*)(sP + t * 72 + 32 * si + 8 * g + 4 * h) = wv; }
        rs += __shfl_xor(rs, 32);
        if (h == 0) sRS[si * 64 + t] = rs;
    } else {
        const int u = F.tid - 256, t = u >> 2, qd = u & 3; const float si_ = sSi[t];
        float dot = 0.f;
#pragma unroll
        for (int j = 0; j < 4; ++j) { const f32x4 n0 = npv[2 * j], n1 = npv[2 * j + 1];
            f32x4 q0, q1; pg8::unpack8(qch[j], q0, q1);
            dot += (q0.x * n0.x + q0.y * n0.y) + (q0.z * n0.z + q0.w * n0.w) + (q1.x * n1.x + q1.y * n1.y) + (q1.z * n1.z + q1.w * n1.w);
            *(LAS v4u*)(sQs + t * 136 + 32 * qd + 8 * j) = pg8::pack8(q0 * si_, q1 * si_); }
        dot += __shfl_xor(dot, 1); dot += __shfl_xor(dot, 2);
        if (qd == 0) sQN[t] = dot;
    }
    __syncthreads();
    {
        f32x16 acc[2];
#pragma unroll
        for (int tt = 0; tt < 2; ++tt) {
            bf16x8 bq_[8], bp_[4];
#pragma unroll
            for (int s = 0; s < 8; ++s) bq_[s] = *(const LAS bf16x8*)(sQs + (32 * tt + n) * 136 + 16 * s + 8 * h);
#pragma unroll
            for (int s = 0; s < 4; ++s) bp_[s] = *(const LAS bf16x8*)(sP + (32 * tt + n) * 72 + 16 * s + 8 * h);
            __builtin_amdgcn_sched_barrier(0);
#pragma unroll
            for (int r = 0; r < 16; ++r) acc[tt][r] = 0.f;
#pragma unroll
            for (int s = 0; s < 8; ++s) acc[tt] = MFMA32(ac[s], bq_[s], acc[tt]);
#pragma unroll
            for (int s = 0; s < 4; ++s) acc[tt] = MFMA32(av[s], bp_[s], acc[tt]);
        }
#pragma unroll
        for (int tt = 0; tt < 2; ++tt) { const int t = 32 * tt + n; const float den = sSi[t] * sQN[t] + sRS[t] + sRS[64 + t]; const float inv = 1.f / fmaxf(fabsf(den), sEmt[t]);
            float ss = 0.f;
#pragma unroll
            for (int r = 0; r < 16; ++r) { acc[tt][r] *= inv; ss += acc[tt][r] * acc[tt][r]; }
            ss += __shfl_xor(ss, 32);
            if (h == 0) sSS[w * 64 + t] = ss; }
        __syncthreads();
#pragma unroll
        for (int tt = 0; tt < 2; ++tt) { const int t = 32 * tt + n; float tot = 0.f;
#pragma unroll
            for (int q = 0; q < 8; ++q) tot += sSS[q * 64 + t];
            const float rn = 1.f / sqrtf(tot * (1.f / 256.f) + EPS);
#pragma unroll
            for (int g = 0; g < 4; ++g) { const int v0 = hd * 256 + 32 * w + 8 * g + 4 * h; const v2u o_ = ow[tt][g];
                const float y0 = acc[tt][4 * g] * rn * nh[g].x * sigmoidf_(bflo(o_.x)), y1 = acc[tt][4 * g + 1] * rn * nh[g].y * sigmoidf_(bfhi(o_.x));
                const float y2 = acc[tt][4 * g + 2] * rn * nh[g].z * sigmoidf_(bflo(o_.y)), y3 = acc[tt][4 * g + 3] * rn * nh[g].w * sigmoidf_(bfhi(o_.y));
                v2u yw; yw.x = cvtpk(y0, y1); yw.y = cvtpk(y2, y3); *(GAS v2u*)(YA + (size_t)(t0 + t) * 1024 + v0) = yw; } }
    }
    __syncthreads();
}

DI void router_block(Frame& F, int rb) {
    LAS float* sLG = (LAS float*)(F.lds + RING_OFF);
    LAS float* sSSq = sLG + 4 * 64 * 33;
    LAS float* sRstd = sSSq + 256;
    LAS int* sCnt = (LAS int*)(sRstd + 64);
    LAS int* sBase = sCnt + 32;
    LAS int* sPE = sBase + 32;
    const int row0 = 64 * rb, n = F.lane & 31, h = F.lane >> 5;
    const bf16* X2 = WSP(const bf16, WS_X2);
    if (F.tid < 32) sCnt[F.tid] = 0;
    {   const int rt = F.wave >> 2, kq = F.wave & 3;
        const bf16* xr = X2 + (size_t)(row0 + 32 * rt + n) * D + 512 * kq + 8 * h;
        const bf16* wh = WSP(const bf16, WS_WRH) + (size_t)n * D + 512 * kq + 8 * h; const bf16* wl = WSP(const bf16, WS_WRL) + (size_t)n * D + 512 * kq + 8 * h;
        f32x16 acc;
#pragma unroll
        for (int r = 0; r < 16; ++r) acc[r] = 0.f;
        float ss = 0.f;
#pragma unroll 1
        for (int s0 = 0; s0 < 32; s0 += 8) {
            v4u xw[8]; bf16x8 bh[8], bl[8];
#pragma unroll
            for (int i = 0; i < 8; ++i) { xw[i] = *(const GAS v4u*)(xr + 16 * (s0 + i)); bh[i] = *(const GAS bf16x8*)(wh + 16 * (s0 + i)); bl[i] = *(const GAS bf16x8*)(wl + 16 * (s0 + i)); }
            __builtin_amdgcn_sched_barrier(0);
#pragma unroll
            for (int i = 0; i < 8; ++i) { f32x4 x0, x1; pg8::unpack8(xw[i], x0, x1);
                ss += (x0.x * x0.x + x0.y * x0.y) + (x0.z * x0.z + x0.w * x0.w) + (x1.x * x1.x + x1.y * x1.y) + (x1.z * x1.z + x1.w * x1.w);
                const bf16x8 ah = __builtin_bit_cast(bf16x8, xw[i]);
                acc = MFMA32(ah, bh[i], acc); acc = MFMA32(ah, bl[i], acc); }
        }
        ss += __shfl_xor(ss, 32);
        if (h == 0) sSSq[kq * 64 + 32 * rt + n] = ss;
#pragma unroll
        for (int r = 0; r < 16; ++r) sLG[(kq * 64 + 32 * rt + crow(r, h)) * 33 + n] = acc[r];
    }
    __syncthreads();
    int myE[4] = {0, 0, 0, 0}, myP[4] = {0, 0, 0, 0};
    {
#pragma unroll
        for (int q = 0; q < 4; ++q) { const int idx = F.tid + 512 * q, r = idx >> 5, e = idx & 31;
            const float ss = (sSSq[r] + sSSq[64 + r]) + (sSSq[128 + r] + sSSq[192 + r]); const float rstd = 1.f / sqrtf(ss * (1.f / D) + EPS); if (e == 0) sRstd[r] = rstd;
            sLG[r * 33 + e] = rstd * ((sLG[r * 33 + e] + sLG[(64 + r) * 33 + e]) + (sLG[(128 + r) * 33 + e] + sLG[(192 + r) * 33 + e])) + F.b_r[e]; } }
    __syncthreads();
    if (F.tid < 64) {
        const int r = F.tid;
        unsigned used = 0u; float tv[4];
#pragma unroll
        for (int k = 0; k < 4; ++k) { float best = -3.4e38f; int bi = 0;
            for (int e = 0; e < NE; ++e) { const float v = sLG[r * 33 + e]; if (!((used >> e) & 1u) && v > best) { best = v; bi = e; } }
            used |= 1u << bi; tv[k] = best; myE[k] = bi; }
        const float e1 = __expf(tv[1] - tv[0]), e2 = __expf(tv[2] - tv[0]), e3 = __expf(tv[3] - tv[0]), inv = 1.f / (1.f + e1 + e2 + e3);
        float* PG = WSP(float, WS_PG) + (size_t)(row0 + r) * 4; *(GAS f32x4*)PG = (f32x4){inv, e1 * inv, e2 * inv, e3 * inv};
#pragma unroll
        for (int k = 0; k < 4; ++k) myP[k] = atomicAdd((int*)&sCnt[myE[k]], 1);
    }
    __syncthreads();
    if (F.tid < 32) sBase[F.tid] = (int)__hip_atomic_fetch_add((unsigned*)(F.ctl + CW_CNT + 64 * F.tid), (unsigned)sCnt[F.tid], RLX_AGENT);
    __syncthreads();
    if (F.tid < 64) { int* PE = WSP(int, WS_PE) + (size_t)(row0 + F.tid) * 4; int* LIST = WSP(int, WS_LIST);
#pragma unroll
        for (int k = 0; k < 4; ++k) { const int pos = sBase[myE[k]] + myP[k]; PE[k] = myE[k] + 32 * pos; LIST[myE[k] * 16384 + pos] = row0 + F.tid; } }
    {
        f32x4 g[8]; { const GAS f32x4* gr = (const GAS f32x4*)F.norm_ffn + F.lane;
#pragma unroll
            for (int j = 0; j < 8; ++j) g[j] = gr[64 * j]; }
#pragma unroll 1
        for (int rr = 0; rr < 64 / NWAVES; rr += 4) {
            v2u xw[4][8]; float rs[4];
#pragma unroll
            for (int q = 0; q < 4; ++q) { const int r = F.wave + NWAVES * (rr + q); const GAS v2u* xr = (const GAS v2u*)(X2 + (size_t)(row0 + r) * D) + F.lane; rs[q] = sRstd[r];
#pragma unroll
                for (int j = 0; j < 8; ++j) xw[q][j] = xr[64 * j]; }
#pragma unroll
            for (int q = 0; q < 4; ++q) { const int r = F.wave + NWAVES * (rr + q);
                if (kFp8Up) { GAS unsigned* o4 = (GAS unsigned*)(F.ws + WS_H2 + (size_t)(row0 + r) * D) + F.lane;
#pragma unroll
                    for (int j = 0; j < 8; ++j) { const f32x4 v = (f32x4){bflo(xw[q][j].x), bfhi(xw[q][j].x), bflo(xw[q][j].y), bfhi(xw[q][j].y)} * rs[q] * g[j]; o4[64 * j] = pk4_fp8(v.x, v.y, v.z, v.w); } }
                else { GAS v2u* o8 = (GAS v2u*)(WSP(bf16, WS_H2) + (size_t)(row0 + r) * D) + F.lane;
#pragma unroll
                    for (int j = 0; j < 8; ++j) { const f32x4 v = (f32x4){bflo(xw[q][j].x), bfhi(xw[q][j].x), bflo(xw[q][j].y), bfhi(xw[q][j].y)} * rs[q] * g[j]; v2u w; w.x = cvtpk(v.x, v.y); w.y = cvtpk(v.z, v.w); o8[64 * j] = w; } }
            }
        }
    }
    __syncthreads();
}

DI int moe_plan(Frame& F, int NT, int gather, const float* bsrc) {
    LAS int* tst = (LAS int*)(F.lds + TST_OFF); LAS int* cntl = tst + 40; LAS int* utab = (LAS int*)(F.lds + UTAB_OFF); LAS unsigned short* tok = (LAS unsigned short*)(F.lds + TOK_OFF); LAS float* bias = (LAS float*)(F.lds + BIAS_OFF);
    if (F.wave == 0) {
        const int cv = (F.lane < 32) ? (int)__hip_atomic_load((unsigned*)(F.ctl + CW_CNT + 64 * (F.lane & 31)), RLX_AGENT) : 0, tl = (cv + 255) >> 8;
        int inc = tl;
#pragma unroll
        for (int o = 1; o < 32; o <<= 1) { const int v = __shfl_up(inc, o); if (F.lane >= o) inc += v; }
        if (F.lane < 32) { cntl[F.lane] = cv; tst[F.lane] = inc - tl; }
        if (F.lane == 31) tst[32] = inc; }
    __syncthreads();
    const int T = tst[32];
    const bool xm = (F.G == 256); const int xq = F.bx & 7, wq = F.bx >> 3, NJ = 256 / NT;
    const int joff = xm ? ((NT == 16) ? 4 * (xq >> 1) + (wq >> 3) : 4 * xq + (wq >> 3)) : 0, pfix = xm ? ((NT == 16) ? 8 * (xq & 1) + (wq & 7) : (wq & 7)) : 0;
    int nu = 0;
    if (xm) { while (nu < MAX_UNITS && NJ * nu + joff < T) ++nu; } else { for (long L = F.bx; L < (long)T * NT && nu < MAX_UNITS; L += F.G) ++nu; }
    if (F.tid < nu) { int j, pnl; if (xm) { j = NJ * F.tid + joff; pnl = pfix; } else { const int L = F.tid * F.G + F.bx; j = L / NT; pnl = L % NT; }
        int e = 0;
        for (int q = 1; q < NE; ++q) if (tst[q] <= j) e = q;
        utab[2 * F.tid] = j; utab[2 * F.tid + 1] = e * NT + pnl; utab[2 * MAX_UNITS + F.tid] = e; utab[3 * MAX_UNITS + F.tid] = (gather == 2) ? j * 256 : 0; }
    __syncthreads();
    const int* LIST = WSP(const int, WS_LIST);
    if (nu > 0) {
        constexpr int NIT = MAX_UNITS * 256 / 512;
        int tv[NIT]; float bv[NIT];
#pragma unroll
        for (int q = 0; q < NIT; ++q) { const int i0 = F.tid + 512 * q, i = (i0 < nu * 256) ? i0 : (F.tid & 255);
            const int ui = i >> 8, r = i & 255, j = utab[2 * ui], e = utab[2 * MAX_UNITS + ui], pnl = utab[2 * ui + 1] - e * NT;
            if (gather == 1) { const int pos = (j - tst[e]) * 256 + r, cnt = cntl[e]; const int t = LIST[e * 16384 + ((pos < cnt) ? pos : 0)]; tv[q] = (pos < cnt) ? t : 0;
                bv[q] = bsrc[(size_t)e * 4096 + (r < 128 ? 0 : 2048) + pnl * 128 + (r & 127)]; }
            else { tv[q] = r; bv[q] = bsrc[(size_t)e * D + pnl * 256 + r]; } }
#pragma unroll
        for (int q = 0; q < NIT; ++q) { const int i0 = F.tid + 512 * q; if (i0 < nu * 256) { tok[i0] = (unsigned short)tv[q]; bias[i0] = bv[q]; } }
    }
    VM_WAIT();
    __syncthreads();
    return nu;
}

DI void final_rows(Frame& F) {
    LAS int* tst = (LAS int*)(F.lds + TST_OFF); LAS int* cntl = tst + 40;
    if (F.wave == 0) {
        const int cv = (F.lane < 32) ? (int)__hip_atomic_load((unsigned*)(F.ctl + CW_CNT + 64 * (F.lane & 31)), RLX_AGENT) : 0, tl = (cv + 255) >> 8;
        int inc = tl;
#pragma unroll
        for (int o = 1; o < 32; o <<= 1) { const int v = __shfl_up(inc, o); if (F.lane >= o) inc += v; }
        if (F.lane < 32) { cntl[F.lane] = cv; tst[F.lane] = inc - tl; }
        if (F.lane == 31) tst[32] = inc; }
    __syncthreads();
    const int gw = F.bx * NWAVES + F.wave, NGW = F.G * NWAVES;
    const bf16* X2 = WSP(const bf16, WS_X2); const int* PE = WSP(const int, WS_PE); const float* PG = WSP(const float, WS_PG);
    f32x4 g[8]; v2u xn[8]; v4i pen; f32x4 pgn;
    { const GAS f32x4* gr = (const GAS f32x4*)F.norm_final + F.lane;
#pragma unroll
      for (int j = 0; j < 8; ++j) g[j] = gr[64 * j];
      const int m0 = gw < M ? gw : 0; const GAS v2u* xr = (const GAS v2u*)(X2 + (size_t)m0 * D) + F.lane;
#pragma unroll
      for (int j = 0; j < 8; ++j) xn[j] = xr[64 * j];
      pen = *(const GAS v4i*)(PE + (size_t)m0 * 4); pgn = *(const GAS f32x4*)(PG + (size_t)m0 * 4); }
    for (int m = gw; m < M; m += NGW) {
        f32x4 v[8]; const v4i pe4 = pen; const f32x4 pg4 = pgn;
#pragma unroll
        for (int j = 0; j < 8; ++j) v[j] = (f32x4){bflo(xn[j].x), bfhi(xn[j].x), bflo(xn[j].y), bfhi(xn[j].y)};
        unsigned yw[4][8];
#pragma unroll
        for (int k = 0; k < 4; ++k) { const int pe = __builtin_amdgcn_readfirstlane(pe4[k]); const int e = pe & 31, pos = pe >> 5;
            const GAS unsigned* yr = (const GAS unsigned*)(F.ws + WS_YM + ((size_t)tst[e] * 256 + pos) * D) + F.lane;
#pragma unroll
            for (int j = 0; j < 8; ++j) yw[k][j] = yr[64 * j]; }
        { const int mn = (m + NGW < M) ? m + NGW : m; const GAS v2u* xr = (const GAS v2u*)(X2 + (size_t)mn * D) + F.lane;
#pragma unroll
          for (int j = 0; j < 8; ++j) xn[j] = xr[64 * j];
          pen = *(const GAS v4i*)(PE + (size_t)mn * 4); pgn = *(const GAS f32x4*)(PG + (size_t)mn * 4); }
#pragma unroll
        for (int k = 0; k < 4; ++k) { const float gk = pg4[k] * YM_INV;
#pragma unroll
            for (int j = 0; j < 8; ++j) { const int w = (int)yw[k][j]; const f32x2 lo = __builtin_amdgcn_cvt_pk_f32_fp8(w, false), hi = __builtin_amdgcn_cvt_pk_f32_fp8(w, true);
                v[j].x += gk * lo.x; v[j].y += gk * lo.y; v[j].z += gk * hi.x; v[j].w += gk * hi.y; } }
        float ss = 0.f;
#pragma unroll
        for (int j = 0; j < 8; ++j) ss += (v[j].x * v[j].x + v[j].y * v[j].y) + (v[j].z * v[j].z + v[j].w * v[j].w);
        const float rstd = 1.f / sqrtf(wave_sum(ss) * (1.f / D) + EPS);
        GAS f32x4* orow = (GAS f32x4*)(F.out + (size_t)m * D) + F.lane;
#pragma unroll
        for (int j = 0; j < 8; ++j) orow[64 * j] = v[j] * rstd * g[j];
    }
}

struct Args { const float* in[20]; float* out; unsigned char* ws; int ph_lo, ph_hi, li, pad; };
__global__ void __launch_bounds__(NWAVES * 64, 2) mk_fwd(Args args) {
    extern __shared__ __attribute__((aligned(16))) unsigned char lds[];
    Frame F;
    F.lds = (LAS unsigned char*)lds; F.ws = args.ws; F.ctl = (gu32*)(args.ws + WS_CTL);
    F.tid = threadIdx.x; F.lane = F.tid & 63; F.wave = __builtin_amdgcn_readfirstlane(F.tid >> 6); F.G = gridDim.x; F.bx = blockIdx.x;
    F.x = args.in[0]; F.norm_mix = args.in[1]; F.w_in = args.in[2]; F.conv_w = args.in[3]; F.conv_b = args.in[4]; F.b_if = args.in[5]; F.norm_head = args.in[6]; F.w_pa = args.in[7]; F.w_pb = args.in[8];
    F.w_mg = args.in[9]; F.b_mg = args.in[10]; F.w_out = args.in[11]; F.norm_ffn = args.in[12]; F.w_r = args.in[13]; F.b_r = args.in[14]; F.w_gu = args.in[15]; F.b_gu = args.in[16]; F.w_dn = args.in[17];
    F.b_dn = args.in[18]; F.norm_final = args.in[19]; F.out = args.out;
    volatile LAS unsigned* MISC = (volatile LAS unsigned*)(F.lds + MISC_OFF);
    if (F.tid < 32) MISC[F.tid] = 0u;
    __syncthreads();
    XcdBarrier bar; bar.bar = (unsigned*)(F.ctl + CW_BAR); bar.x = 0; bar.st = nullptr;
    if (N_LAUNCHES != PER_PHASE) bar = xcd_barrier_post((unsigned*)(F.ctl + CW_BAR), MISC + 8);
#define GRID_BAR() do { if (N_LAUNCHES != PER_PHASE) xcd_barrier(bar); } while (0)
    const int lo = args.ph_lo, hi = args.ph_hi;
#ifndef PHMASK
#define PHMASK 0x7ff
#endif
#define IN(k) (((PHMASK >> (k)) & 1) && lo <= (k) && (k) < hi)
#define BOTH(k) (IN(k) && IN((k) + 1))
#ifndef DUP_MASK
#define DUP_MASK 0
#endif
#define REPS(k) (((DUP_MASK >> (k)) & 1) ? 2 : 1)
#define PH_BEGIN(k) if (IN(k)) { _Pragma("unroll") for (int rep_ = 0; rep_ < REPS(k); ++rep_) {
#define PH_END(k) if (BOTH(k) || rep_ + 1 < REPS(k)) GRID_BAR(); } }

    PH_BEGIN(0) p0_prologue(F); PH_END(0)

    PH_BEGIN(1)
        if (F.bx >= NCONV_WG && F.G > NCONV_WG) { const int Gg = F.G - NCONV_WG, cg = F.bx - NCONV_WG;
#define P1_QKO() { pg8::Gemm g{WSP(const bf16, WS_H), WSP(const bf16, WS_W1N), M, 4096, D}; pg8::StaticOrder S; S.init(M, 4096, Gg, cg); \
          pg8::EpiPlain E{WSP(bf16, WS_QKO), 4096}; \
          pg8::gemm_phase<pg8::EpiPlain, pg8::StaticOrder, true, false>(F.lds + RING_OFF, g, S, E); }
#define P1_GATE() { pg8::Gemm g{WSP(const bf16, WS_H8), WSP(const bf16, WS_WMG8), M, 4096, D / 2}; pg8::StaticOrder S; S.init(M, 4096, Gg, cg); S.rowbytes = D; \
          pg8::EpiGate E{WSP(bf16, WS_GT), F.b_mg}; \
          pg8::gemm_phase<pg8::EpiGate, pg8::StaticOrder, true, true, true>(F.lds + RING_OFF, g, S, E); }
#define P1_VT() { pg8::Gemm g{WSP(const bf16, WS_W1V), WSP(const bf16, WS_H), 2048, M, D}; pg8::StaticOrder S; S.init(2048, M, Gg, cg); \
          pg8::EpiVT E{WSP(bf16, WS_VT)}; \
          pg8::gemm_phase<pg8::EpiVT, pg8::StaticOrder, true, false>(F.lds + RING_OFF, g, S, E); }
        if ((F.bx >> 3) & 1) { P1_GATE() P1_VT() P1_QKO() } else { P1_QKO() P1_GATE() P1_VT() }
#undef P1_QKO
#undef P1_GATE
#undef P1_VT
        }
        conv_queue(F);
    PH_END(1)

    PH_BEGIN(2)
        for (int u = F.bx; u < 4 * NCH; u += F.G) mlstm_a_unit(F, u >> 8, u & 255);
        { const int gw = F.bx * NWAVES + F.wave, NGW = F.G * NWAVES;
          for (int u = gw; u < 8 * (M / 32); u += NGW) attn_wave_unit(WSP(const bf16, WS_QKO), WSP(const bf16, WS_VT), WSP(bf16, WS_YB), u / (M / 32), u % (M / 32), F.lane, F.lds + RING_OFF + F.wave * 18944); }
    PH_END(2)

    PH_BEGIN(3) mlstm_scan(F); PH_END(3)

    PH_BEGIN(4) for (int u = F.bx; u < 4 * NCH; u += F.G) mlstm_c_unit(F, u >> 8, u & 255); PH_END(4)

    PH_BEGIN(5)
        { pg8::Gemm g{WSP(const bf16, WS_YA), WSP(const bf16, WS_WPA), M, D, 1024}; pg8::StaticOrder S; S.init(M, D, F.G, F.bx);
          pg8::EpiMix<false> E{WSP(bf16, WS_MIX), WSP(bf16, WS_X2 + 64 * MiB), WSP(const bf16, WS_GT), 0};
          pg8::gemm_phase<pg8::EpiMix<false>, pg8::StaticOrder, true, false>(F.lds + RING_OFF, g, S, E); }
        { pg8::Gemm g{WSP(const bf16, WS_YB), WSP(const bf16, WS_WPB), M, D, 1024}; pg8::StaticOrder S; S.init(M, D, F.G, F.bx);
          pg8::EpiMix<true> E{WSP(bf16, WS_MIX), WSP(bf16, WS_X2 + 64 * MiB), WSP(const bf16, WS_GT), 8};
          pg8::gemm_phase<pg8::EpiMix<true>, pg8::StaticOrder, true, false>(F.lds + RING_OFF, g, S, E); }
    PH_END(5)

    PH_BEGIN(6)
        pg8::Gemm g{WSP(const bf16, WS_MIX), WSP(const bf16, WS_WOT), M, D, kFp8Out ? D / 2 : D}; pg8::StaticOrder S; S.init(M, D, F.G, F.bx); S.rowbytes = kFp8Out ? D : 2 * D;
        pg8::EpiX2 E{F.x, WSP(bf16, WS_X2)};
        if constexpr (kFp8Out) pg8::gemm_phase<pg8::EpiX2, pg8::StaticOrder, true, true, true>(F.lds + RING_OFF, g, S, E);
        else pg8::gemm_phase<pg8::EpiX2, pg8::StaticOrder, true, false>(F.lds + RING_OFF, g, S, E);
    PH_END(6)

    PH_BEGIN(7) for (int rb = F.bx; rb < M / 64; rb += F.G) router_block(F, rb); PH_END(7)

    PH_BEGIN(8)
        const int nu = moe_plan(F, 16, 1, F.b_gu);
        pg8::Gemm g{WSP(const bf16, WS_H2), WSP(const bf16, WS_WGU), M, 4096, kFp8Up ? D / 2 : D};
        pg8::MoeOrder S{(const LAS int*)(F.lds + UTAB_OFF), (const LAS unsigned short*)(F.lds + TOK_OFF), __builtin_amdgcn_readfirstlane(nu), kFp8Up ? (unsigned)D : 2u * D, MAX_UNITS};
        pg8::EpiMoeUp<kFp8Dn> E{WSP(bf16, WS_ACT), (const LAS float*)(F.lds + BIAS_OFF)};
        pg8::gemm_phase<pg8::EpiMoeUp<kFp8Dn>, pg8::MoeOrder, true, true, kFp8Up>(F.lds + RING_OFF, g, S, E);
    PH_END(8)

    PH_BEGIN(9)
        const int nu = moe_plan(F, 8, 2, F.b_dn);
        pg8::Gemm g{WSP(const bf16, WS_ACT), WSP(const bf16, WS_WDN), ACT_ROWS, D, kFp8Dn ? DFF / 2 : DFF};
        pg8::MoeOrder S{(const LAS int*)(F.lds + UTAB_OFF), (const LAS unsigned short*)(F.lds + TOK_OFF), __builtin_amdgcn_readfirstlane(nu), kFp8Dn ? (unsigned)DFF : 2u * DFF, MAX_UNITS};
        pg8::EpiMoeDn E{F.ws + WS_YM, (const LAS float*)(F.lds + BIAS_OFF)};
        pg8::gemm_phase<pg8::EpiMoeDn, pg8::MoeOrder, true, true, kFp8Dn>(F.lds + RING_OFF, g, S, E);
    PH_END(9)

    PH_BEGIN(10) final_rows(F); PH_END(10)
#undef IN
#undef BOTH
}

extern "C" void kernel_launch(void* const* d_in, const int* in_sizes, int n_in, void* d_out, int out_size, void* d_ws, size_t ws_size, hipStream_t stream) {
    static int grid = 0;
    if (grid == 0) {
        if (n_in != 20 || out_size != M * D || ws_size < WS_END) { fprintf(stderr, "kernel_launch: unexpected problem (n_in %d, out %d, ws %zu < %zu)\n", n_in, out_size, ws_size, (size_t)WS_END); grid = -1; return; }
        int dev = 0, cus = 0, per_cu = 0;
        if (hipGetDevice(&dev) != hipSuccess || hipDeviceGetAttribute(&cus, hipDeviceAttributeMultiprocessorCount, dev) != hipSuccess) { grid = -1; return; }
        if (hipFuncSetAttribute((const void*)mk_fwd, hipFuncAttributeMaxDynamicSharedMemorySize, LDS_BYTES) != hipSuccess) { fprintf(stderr, "kernel_launch: hipFuncSetAttribute failed\n"); grid = -1; return; }
        if (hipOccupancyMaxActiveBlocksPerMultiprocessor(&per_cu, (const void*)mk_fwd, NWAVES * 64, LDS_BYTES) != hipSuccess || per_cu < 1) { fprintf(stderr, "kernel_launch: occupancy query reports %d\n", per_cu); }
        (void)hipGetLastError();
        grid = cus;
        if (grid > 256) grid = 256;
    }
    if (grid < 0) return;
    (void)hipMemsetAsync((char*)d_ws + WS_CTL, 0, CTL_ZERO_BYTES, stream);
    Args a{};
    for (int i = 0; i < 20; ++i) a.in[i] = (const float*)d_in[i];
    a.out = (float*)d_out; a.ws = (unsigned char*)d_ws;
    if (N_LAUNCHES == 1) { a.ph_lo = 0; a.ph_hi = PER_PHASE; a.li = 0; hipLaunchKernelGGL(mk_fwd, dim3(grid), dim3(NWAVES * 64), LDS_BYTES, stream, a); }
    else for (int li = 0; li < PER_PHASE; ++li) { a.ph_lo = li; a.ph_hi = li + 1; a.li = li; hipLaunchKernelGGL(mk_fwd, dim3(grid), dim3(NWAVES * 64), LDS_BYTES, stream, a); }
    const hipError_t le = hipPeekAtLastError();
    if (le != hipSuccess) fprintf(stderr, "kernel_launch: launch failed: %s\n", hipGetErrorName(le));
}
```

```cpp
#include <hip/hip_runtime.h>
#include <cstdio>
#include <type_traits>

#define GAS __attribute__((address_space(1)))
#define LAS __attribute__((address_space(3)))
typedef unsigned short bf16;
typedef unsigned v4u __attribute__((ext_vector_type(4)));
typedef unsigned v2u __attribute__((ext_vector_type(2)));
typedef float f32x4 __attribute__((ext_vector_type(4)));
typedef float f32x2 __attribute__((ext_vector_type(2)));
typedef float f32x16 __attribute__((ext_vector_type(16)));
typedef short bf16x8 __attribute__((ext_vector_type(8)));
typedef int v4i __attribute__((ext_vector_type(4)));
typedef int v8i __attribute__((ext_vector_type(8)));
typedef short s16x16 __attribute__((ext_vector_type(16)));
typedef short bf16x4 __attribute__((ext_vector_type(4)));
typedef __bf16 bf16x2_t __attribute__((ext_vector_type(2)));
typedef GAS unsigned gu32;
#define RLX_AGENT __ATOMIC_RELAXED, __HIP_MEMORY_SCOPE_AGENT
#define LDS_WAIT() asm volatile("s_waitcnt lgkmcnt(0)" ::: "memory")
#define VM_WAIT() asm volatile("s_waitcnt vmcnt(0)" ::: "memory")
#define DI __device__ __forceinline__

DI unsigned cvtpk(float lo, float hi) { f32x2 v = {lo, hi}; bf16x2_t b = __builtin_convertvector(v, bf16x2_t); return __builtin_bit_cast(unsigned, b); }
DI float bflo(unsigned w) { return __builtin_bit_cast(float, w << 16); }
DI float bfhi(unsigned w) { return __builtin_bit_cast(float, w & 0xffff0000u); }
DI float bf2f(bf16 b) { return __builtin_bit_cast(float, ((unsigned)b) << 16); }
DI bf16 f2bf(float f) { return (bf16)(cvtpk(f, 0.f) & 0xffffu); }
DI unsigned pk4_fp8(float a, float b, float c, float d) { int w = 0; w = __builtin_amdgcn_cvt_pk_fp8_f32(a, b, w, false); w = __builtin_amdgcn_cvt_pk_fp8_f32(c, d, w, true); return (unsigned)w; }
DI float sigmoidf_(float x) { return __builtin_amdgcn_rcpf(1.f + __expf(-x)); }
DI float wave_sum(float v) {
#pragma unroll
    for (int o = 1; o < 64; o <<= 1) v += __shfl_xor(v, o);
    return v;
}
DI float wave_max(float v) {
#pragma unroll
    for (int o = 1; o < 64; o <<= 1) v = fmaxf(v, __shfl_xor(v, o));
    return v;
}
DI int crow(int reg, int h) { return (reg & 3) + 8 * (reg >> 2) + 4 * h; }
#define MFMA32(a, b, c) __builtin_amdgcn_mfma_f32_32x32x16_bf16((a), (b), (c), 0, 0, 0)

constexpr int M = 16384, D = 2048;
constexpr int INC = 6152;
constexpr int NE = 32, DFF = 2048, TOPK = 4;
constexpr int NCH = 256, CH = 64;
constexpr float EPS = 1e-5f;
constexpr size_t VT_B = (size_t)4 * 256 * 256 * 64;
constexpr int ACT_ROWS = 65536 + 32 * 256;
constexpr float YM_SCALE = 16.f, YM_INV = 1.f / 16.f;

#ifndef FP8_OUT
#define FP8_OUT 0
#endif
#ifndef FP8_QK
#define FP8_QK 1
#endif
constexpr bool kFp8Qk = FP8_QK;
constexpr bool kFp8Out = FP8_OUT;
namespace pg8 {
#define PG8_LAS __attribute__((address_space(3)))
typedef unsigned short bf16_t;
typedef unsigned u32x4 __attribute__((ext_vector_type(4)));
constexpr int BM = 256, BK = 64, HALF = 128, HTB = HALF * BK * 2, STAGE_BYTES = 8 * HTB, NXCD = 8, WGM = 4;
__host__ __device__ __forceinline__ int lds_byte(int r, int c) { const int st = (r >> 4) * 2 + (c >> 5), rr = r & 15, cc = c & 31, ob = rr * 64 + cc * 2; return st * 1024 + (ob ^ (((ob >> 9) & 1) << 5)); }
__host__ __device__ __forceinline__ void stage_rc(int b, int& R, int& C) { const int st = b / 1024, sb = b % 1024, swz = sb ^ (((sb >> 9) & 1) << 5); R = (st >> 1) * 16 + swz / 64; C = (st & 1) * 32 + (swz % 64) / 2; }
__host__ __device__ __forceinline__ int perm32(int rho) { const int n = rho >> 4, i = rho & 15; return 8 * (i >> 2) + 4 * n + (i & 3); }

struct Unit { int pm, pn, ui; };
struct Gemm { const bf16_t* A; const bf16_t* Bt; int M, N, K; };

struct StaticOrder {
    int nM, nN, nwg, G, c;
    __device__ void init(int M_, int N_, int G_, int c_) { nM = M_ / BM; nN = N_ / BM; nwg = nM * nN; G = G_; c = c_; }
    __device__ bool next(int i, Unit& u) const {
        const long L = (long)i * G + c; if (L >= nwg) return false;
        int wgid = (int)L; { const int q = nwg / NXCD, r = nwg % NXCD, xcd = wgid % NXCD, off = wgid / NXCD; wgid = (xcd < r ? xcd * (q + 1) : r * (q + 1) + (xcd - r) * q) + off; }
        const int nig = WGM * nN, gid = wgid / nig, fm = gid * WGM, gsz = (nM - fm) < WGM ? (nM - fm) : WGM;
        u.pm = __builtin_amdgcn_readfirstlane(fm + ((wgid % nig) % gsz)); u.pn = __builtin_amdgcn_readfirstlane((wgid % nig) / gsz); u.ui = i; return true;
    }
    unsigned rowbytes;
    __device__ __forceinline__ unsigned tok(int i, int r) const { Unit u; (void)next(i, u); return (unsigned)(u.pm * BM + r) * rowbytes; }
};
struct MoeOrder {
    const PG8_LAS int* tab; const PG8_LAS unsigned short* tok16; int n; unsigned rowbytes; int maxu;
    __device__ __forceinline__ bool next(int i, Unit& u) const { if (i >= n) return false; u.pm = __builtin_amdgcn_readfirstlane(tab[2 * i]); u.pn = __builtin_amdgcn_readfirstlane(tab[2 * i + 1]); u.ui = i; return true; }
    __device__ __forceinline__ unsigned tok(int i, int r) const { return ((unsigned)tab[3 * maxu + i] + (unsigned)tok16[i * 256 + r]) * rowbytes; }
};

__device__ __forceinline__ f32x4 mma8(const bf16x8& b0, const bf16x8& b1, const bf16x8& a0, const bf16x8& a1, const f32x4& c) {
    const v8i b = __builtin_shufflevector(__builtin_bit_cast(v4i, b0), __builtin_bit_cast(v4i, b1), 0, 1, 2, 3, 4, 5, 6, 7), a = __builtin_shufflevector(__builtin_bit_cast(v4i, a0), __builtin_bit_cast(v4i, a1), 0, 1, 2, 3, 4, 5, 6, 7);
    return __builtin_amdgcn_mfma_scale_f32_16x16x128_f8f6f4(b, a, c, 0, 0, 0, 0x79797979, 0, 0x7f7f7f7f); }
template <class Epi, class Sched, bool ALIGN_EPI, bool GATHER, bool FP8 = false>
__device__ __forceinline__ void gemm_phase(PG8_LAS unsigned char* lds, const Gemm g, const Sched& S, const Epi& E) {
    const int tid = threadIdx.x, wid = __builtin_amdgcn_readfirstlane(tid >> 6), lane = tid & 63, wr = wid >> 2, wc = wid & 3, fr = lane & 15, fq = lane >> 4;
    const int K = g.K, nt = K / BK;
    unsigned voffA[2], voffB[2]; int rowA[2]; unsigned colA[2];
#pragma unroll
    for (int i = 0; i < 2; ++i) { int R, C; stage_rc(tid * 16 + i * 8192, R, C); const int Rb = Epi::PERM ? ((R & ~31) + perm32(R & 31)) : R;
        voffA[i] = (unsigned)(R * K + C) * 2u; voffB[i] = (unsigned)(Rb * K + C) * 2u; rowA[i] = R; colA[i] = (unsigned)C * 2u; }
    const unsigned kstep = (unsigned)(BK * 2);
    const unsigned hstep = (unsigned)HALF * K * 2;
    const unsigned tstep = 2 * hstep;
    const unsigned ldsw = (unsigned)wid * 1024u;
    const int aoff = lds_byte(wr * 64 + fr, fq * 8), boff = lds_byte(wc * 32 + fr, fq * 8);
    constexpr int KSTR = 1024;
#define PG8_SA(b, h) (((b) * 2 + (h)) * HTB)
#define PG8_SB(b, h) ((4 + (b) * 2 + (h)) * HTB)
    const __amdgpu_buffer_rsrc_t rsA = __builtin_amdgcn_make_buffer_rsrc((void*)g.A, 0, 0xffffffffu, 0x00020000), rsB = __builtin_amdgcn_make_buffer_rsrc((void*)g.Bt, 0, 0xffffffffu, 0x00020000);
#define PG8_STAGE(bufoff, soff, voff) do { _Pragma("unroll") for (int _i = 0; _i < 2; ++_i) \
        __builtin_amdgcn_raw_ptr_buffer_load_lds(rsB, (PG8_LAS unsigned*)(lds + (bufoff) + ldsw + _i * 8192), 16, (int)(voff)[_i], (int)(soff), 0, 0); } while (0)
#define PG8_STAGE_A(bufoff, ubase, V, kb, h) do { _Pragma("unroll") for (int _i = 0; _i < 2; ++_i) { \
        if constexpr (GATHER) __builtin_amdgcn_raw_ptr_buffer_load_lds(rsA, (PG8_LAS unsigned*)(lds + (bufoff) + ldsw + _i * 8192), 16, (int)(V)[h][_i], (int)(kb), 0, 0); \
        else __builtin_amdgcn_raw_ptr_buffer_load_lds(rsA, (PG8_LAS unsigned*)(lds + (bufoff) + ldsw + _i * 8192), 16, (int)voffA[_i], (int)((ubase) + (kb) + (unsigned)(h) * hstep), 0, 0); } } while (0)
#define PG8_LDA(dst, b, h) do { _Pragma("unroll") for (int m = 0; m < 4; ++m) _Pragma("unroll") for (int k = 0; k < 2; ++k) dst[m][k] = *(const PG8_LAS bf16x8*)(lds + PG8_SA(b, h) + aoff + m * 2048 + k * KSTR); } while (0)
#define PG8_LDB(dst, b, h) do { _Pragma("unroll") for (int n = 0; n < 2; ++n) _Pragma("unroll") for (int k = 0; k < 2; ++k) dst[n][k] = *(const PG8_LAS bf16x8*)(lds + PG8_SB(b, h) + boff + n * 2048 + k * KSTR); } while (0)
#define PG8_MMA(ai, bj, At, Bt) do { __builtin_amdgcn_s_setprio(1); _Pragma("unroll") for (int m = 0; m < 4; ++m) _Pragma("unroll") for (int n = 0; n < 2; ++n) { \
        if constexpr (FP8) acc[ai][bj][m][n] = mma8(Bt[n][0], Bt[n][1], At[m][0], At[m][1], acc[ai][bj][m][n]); \
        else { _Pragma("unroll") for (int k = 0; k < 2; ++k) acc[ai][bj][m][n] = __builtin_amdgcn_mfma_f32_16x16x32_bf16(Bt[n][k], At[m][k], acc[ai][bj][m][n], 0, 0, 0); } } __builtin_amdgcn_s_setprio(0); } while (0)
#define PG8_WAIT_V(n) asm volatile("s_waitcnt vmcnt(" #n ")" ::: "memory")
#define PG8_WAIT_L(n) asm volatile("s_waitcnt lgkmcnt(" #n ")" ::: "memory")
#define PG8_BAR __builtin_amdgcn_s_barrier()
#define PG8_SCHED __builtin_amdgcn_sched_barrier(0)
    Unit cur, nxt; int ui = 0;
    if (!S.next(0, cur)) return;
    f32x4 acc[2][2][4][2];
#pragma unroll
    for (int a = 0; a < 2; ++a)
#pragma unroll
        for (int b = 0; b < 2; ++b)
#pragma unroll
            for (int m = 0; m < 4; ++m)
#pragma unroll
                for (int n = 0; n < 2; ++n) acc[a][b][m][n] = (f32x4){0.f, 0.f, 0.f, 0.f};
    bf16x8 At[4][2], B0[2][2], B1[2][2];
    unsigned vg[2][2] = {{0u, 0u}, {0u, 0u}};
    if constexpr (GATHER) {
#pragma unroll
        for (int h = 0; h < 2; ++h)
#pragma unroll
            for (int i = 0; i < 2; ++i) vg[h][i] = S.tok(0, h * HALF + rowA[i]) + colA[i];
    }
    unsigned cA = GATHER ? 0u : (unsigned)cur.pm * tstep, cB = (unsigned)cur.pn * tstep;
    PG8_STAGE(PG8_SB(0, 0), cB, voffB); PG8_STAGE(PG8_SB(0, 1), cB + hstep, voffB); PG8_STAGE_A(PG8_SA(0, 0), cA, vg, 0u, 0); PG8_STAGE_A(PG8_SA(0, 1), cA, vg, 0u, 1);
    if (wr == 1) PG8_BAR;
    PG8_WAIT_V(2); PG8_BAR;
    PG8_STAGE(PG8_SB(1, 0), cB + kstep, voffB); PG8_STAGE_A(PG8_SA(1, 0), cA, vg, kstep, 0); PG8_STAGE(PG8_SB(1, 1), cB + hstep + kstep, voffB);
    PG8_WAIT_V(6); PG8_BAR;
    for (;;) {
        const bool has_next = S.next(ui + 1, nxt);
        const unsigned nA = GATHER ? 0u : (has_next ? (unsigned)nxt.pm * tstep : cA), nB = has_next ? (unsigned)nxt.pn * tstep : cB;
        for (int t = 0; t < nt; t += 2) {
            const bool last = (t == nt - 2);
            const unsigned k1 = (unsigned)(t + 1) * kstep;
            const unsigned a2b = last ? nA : cA; const unsigned k2 = last ? 0u : (unsigned)(t + 2) * kstep, k3 = k2 + kstep;
            const unsigned b2 = last ? nB : cB + (unsigned)(t + 2) * kstep; const unsigned b3 = b2 + kstep;
            PG8_LDB(B0, 0, 0); PG8_LDB(B1, 0, 1); PG8_SCHED; PG8_LDA(At, 0, 0); PG8_STAGE_A(PG8_SA(1, 1), cA, vg, k1, 1);
            if constexpr (GATHER) { if (last && has_next) {
#pragma unroll
                for (int h = 0; h < 2; ++h)
#pragma unroll
                    for (int i = 0; i < 2; ++i) vg[h][i] = S.tok(ui + 1, h * HALF + rowA[i]) + colA[i]; } }
            PG8_WAIT_V(8); PG8_WAIT_L(0); PG8_BAR; PG8_MMA(0, 0, At, B0); PG8_MMA(0, 1, At, B1); PG8_BAR; PG8_SCHED;
            PG8_LDA(At, 0, 1); PG8_STAGE(PG8_SB(0, 0), b2, voffB); PG8_STAGE(PG8_SB(0, 1), b2 + hstep, voffB); PG8_STAGE_A(PG8_SA(0, 0), a2b, vg, k2, 0);
            PG8_WAIT_V(8); PG8_WAIT_L(0); PG8_BAR; PG8_MMA(1, 0, At, B0); PG8_MMA(1, 1, At, B1); PG8_BAR; PG8_SCHED;
            PG8_LDB(B0, 1, 0); PG8_LDB(B1, 1, 1); PG8_SCHED; PG8_LDA(At, 1, 0); PG8_STAGE_A(PG8_SA(0, 1), a2b, vg, k2, 1);
            PG8_WAIT_V(8); PG8_WAIT_L(0); PG8_BAR; PG8_MMA(0, 0, At, B0); PG8_MMA(0, 1, At, B1); PG8_BAR; PG8_SCHED;
            PG8_LDA(At, 1, 1); PG8_STAGE(PG8_SB(1, 0), b3, voffB); PG8_STAGE(PG8_SB(1, 1), b3 + hstep, voffB); PG8_STAGE_A(PG8_SA(1, 0), a2b, vg, k3, 0);
            PG8_WAIT_V(8); PG8_WAIT_L(0); PG8_BAR; PG8_MMA(1, 0, At, B0); PG8_MMA(1, 1, At, B1); PG8_BAR; PG8_SCHED;
        }
        if constexpr (ALIGN_EPI) { if (wr == 0) PG8_BAR; }
        E(acc, cur, wr, wc, fr, fq);
        if (!has_next) break;
#pragma unroll
        for (int a = 0; a < 2; ++a)
#pragma unroll
            for (int b = 0; b < 2; ++b)
#pragma unroll
                for (int m = 0; m < 4; ++m)
#pragma unroll
                    for (int n = 0; n < 2; ++n) acc[a][b][m][n] = (f32x4){0.f, 0.f, 0.f, 0.f};
        cur = nxt; cA = nA; cB = nB; ++ui;
        if constexpr (ALIGN_EPI) { if (wr == 1) PG8_BAR; }
    }
    PG8_WAIT_V(0);
    if constexpr (!ALIGN_EPI) { if (wr == 0) PG8_BAR; }
    PG8_BAR;
#undef PG8_SA
#undef PG8_SB
#undef PG8_STAGE
#undef PG8_STAGE_A
#undef PG8_LDA
#undef PG8_LDB
#undef PG8_MMA
#undef PG8_WAIT_V
#undef PG8_WAIT_L
#undef PG8_BAR
#undef PG8_SCHED
}

#define EPI_ROWS(...) _Pragma("unroll") for (int ai = 0; ai < 2; ++ai) _Pragma("unroll") for (int m = 0; m < 4; ++m) { const int row = u.pm * BM + wr * 64 + fr + ai * HALF + m * 16; \
        _Pragma("unroll") for (int bj = 0; bj < 2; ++bj) { __VA_ARGS__ } }
DI u32x4 pack8(const f32x4& v0, const f32x4& v1) { u32x4 w; w.x = cvtpk(v0[0], v0[1]); w.y = cvtpk(v0[2], v0[3]); w.z = cvtpk(v1[0], v1[1]); w.w = cvtpk(v1[2], v1[3]); return w; }
DI void unpack8(const u32x4& w, f32x4& v0, f32x4& v1) { v0 = (f32x4){bflo(w.x), bfhi(w.x), bflo(w.y), bfhi(w.y)}; v1 = (f32x4){bflo(w.z), bfhi(w.z), bflo(w.w), bfhi(w.w)}; }

struct EpiPlain { static constexpr bool PERM = true; bf16_t* O; int ldc;
    __device__ __forceinline__ void operator()(const f32x4 (&acc)[2][2][4][2], const Unit& u, int wr, int wc, int fr, int fq) const {
        const int col0 = u.pn * BM + wc * 32 + 8 * fq;
        EPI_ROWS( *(u32x4*)(O + (size_t)row * ldc + col0 + bj * HALF) = pack8(acc[ai][bj][m][0], acc[ai][bj][m][1]); )
    } };
struct EpiVT { static constexpr bool PERM = true; bf16_t* VT;
    __device__ __forceinline__ void operator()(const f32x4 (&acc)[2][2][4][2], const Unit& u, int wr, int wc, int fr, int fq) const {
        const int col0 = u.pn * BM + wc * 32 + 8 * fq;
        if (u.pm < 4) {
            EPI_ROWS( const int col = col0 + bj * HALF, hd = row >> 8, v = row & 255;
                *(u32x4*)(VT + ((((size_t)(hd * 256 + (col >> 6)) * 256 + v) << 6) + (col & 63))) = pack8(acc[ai][bj][m][0], acc[ai][bj][m][1]); )
        } else {
            EPI_ROWS( const int col = col0 + bj * HALF, r2 = row - 1024, hd = r2 >> 7, d = r2 & 127;
                *(u32x4*)(VT + VT_B + ((((size_t)(hd * 512 + (col >> 5)) * 128 + d) << 5) + (col & 31))) = pack8(acc[ai][bj][m][0], acc[ai][bj][m][1]); )
        }
    } };
struct EpiGate { static constexpr bool PERM = true; bf16_t* GT; const float* bmg;
    __device__ __forceinline__ void operator()(const f32x4 (&acc)[2][2][4][2], const Unit& u, int wr, int wc, int fr, int fq) const {
        const int col0 = u.pn * BM + wc * 32 + 8 * fq, tl8 = (((wr * 4 + wc) * 64) + fq * 16 + fr) * 8;
        f32x4 bv[2][2];
#pragma unroll
        for (int bj = 0; bj < 2; ++bj)
#pragma unroll
            for (int n = 0; n < 2; ++n) bv[bj][n] = *(const f32x4*)(bmg + col0 + bj * HALF + 4 * n);
        EPI_ROWS( f32x4 v0 = (acc[ai][bj][m][0] + bv[bj][0]) * -1.4426950408889634f, v1 = (acc[ai][bj][m][1] + bv[bj][1]) * -1.4426950408889634f;
            _Pragma("unroll") for (int q = 0; q < 4; ++q) { v0[q] = __builtin_amdgcn_exp2f(v0[q]); v1[q] = __builtin_amdgcn_exp2f(v1[q]); }
            v0 = v0 + 1.0f; v1 = v1 + 1.0f;
            _Pragma("unroll") for (int q = 0; q < 4; ++q) { v0[q] = __builtin_amdgcn_rcpf(v0[q]); v1[q] = __builtin_amdgcn_rcpf(v1[q]); }
            *(u32x4*)(GT + (size_t)(u.pm * 16 + u.pn) * 65536 + ((ai * 4 + m) * 2 + bj) * 4096 + tl8) = pack8(v0, v1); )
    } };
template <bool ADD> struct EpiMix { static constexpr bool PERM = true; bf16_t* MIX; bf16_t* MIXA; const bf16_t* GT; int gt0;
    __device__ __forceinline__ void operator()(const f32x4 (&acc)[2][2][4][2], const Unit& u, int wr, int wc, int fr, int fq) const {
        const int col0 = u.pn * BM + wc * 32 + 8 * fq, tl8 = (((wr * 4 + wc) * 64) + fq * 16 + fr) * 8;
        const bf16_t* gt = GT + (size_t)(u.pm * 16 + u.pn + gt0) * 65536 + tl8; bf16_t* ma = MIXA + (size_t)(u.pm * 8 + u.pn) * 65536 + tl8;
        if constexpr (!ADD) {
            u32x4 gw[2][4][2];
#pragma unroll
            for (int ai = 0; ai < 2; ++ai)
#pragma unroll
                for (int m = 0; m < 4; ++m)
#pragma unroll
                    for (int bj = 0; bj < 2; ++bj) gw[ai][m][bj] = *(const u32x4*)(gt + ((ai * 4 + m) * 2 + bj) * 4096);
            EPI_ROWS( const int go = ((ai * 4 + m) * 2 + bj) * 4096; f32x4 g0, g1; unpack8(gw[ai][m][bj], g0, g1);
                *(u32x4*)(ma + go) = pack8(acc[ai][bj][m][0] * g0, acc[ai][bj][m][1] * g1); )
        } else {
#pragma unroll
            for (int ai = 0; ai < 2; ++ai) {
                u32x4 gw[4][2], pw[4][2];
#pragma unroll
                for (int m = 0; m < 4; ++m)
#pragma unroll
                    for (int bj = 0; bj < 2; ++bj) { const int go = ((ai * 4 + m) * 2 + bj) * 4096; gw[m][bj] = *(const u32x4*)(gt + go); pw[m][bj] = *(const u32x4*)(ma + go); }
#pragma unroll
                for (int m = 0; m < 4; ++m) { const int row = u.pm * BM + wr * 64 + fr + ai * HALF + m * 16;
#pragma unroll
                    for (int bj = 0; bj < 2; ++bj) { f32x4 g0, g1, p0, p1; unpack8(gw[m][bj], g0, g1); unpack8(pw[m][bj], p0, p1);
                        const f32x4 w0 = acc[ai][bj][m][0] * g0 + p0, w1 = acc[ai][bj][m][1] * g1 + p1;
                        if constexpr (kFp8Out) { v2u w; w.x = pk4_fp8(w0[0], w0[1], w0[2], w0[3]); w.y = pk4_fp8(w1[0], w1[1], w1[2], w1[3]); *(v2u*)((unsigned char*)MIX + (size_t)row * D + col0 + bj * HALF) = w; }
                        else *(u32x4*)(MIX + (size_t)row * D + col0 + bj * HALF) = pack8(w0, w1); } }
            }
        }
    } };
struct EpiX2 { static constexpr bool PERM = true; const float* X; bf16_t* X2;
    __device__ __forceinline__ void operator()(const f32x4 (&acc)[2][2][4][2], const Unit& u, int wr, int wc, int fr, int fq) const {
        const int col0 = u.pn * BM + wc * 32 + 8 * fq;
#pragma unroll
        for (int ai = 0; ai < 2; ++ai) {
            f32x4 xv[4][2][2];
#pragma unroll
            for (int m = 0; m < 4; ++m)
#pragma unroll
                for (int bj = 0; bj < 2; ++bj) { const size_t o = (size_t)(u.pm * BM + wr * 64 + fr + ai * HALF + m * 16) * D + col0 + bj * HALF; xv[m][bj][0] = *(const f32x4*)(X + o); xv[m][bj][1] = *(const f32x4*)(X + o + 4); }
#pragma unroll
            for (int m = 0; m < 4; ++m)
#pragma unroll
                for (int bj = 0; bj < 2; ++bj) { const size_t o = (size_t)(u.pm * BM + wr * 64 + fr + ai * HALF + m * 16) * D + col0 + bj * HALF;
                    *(u32x4*)(X2 + o) = pack8(xv[m][bj][0] + acc[ai][bj][m][0], xv[m][bj][1] + acc[ai][bj][m][1]); }
        }
    } };
template <bool OUT8> struct EpiMoeUp { static constexpr bool PERM = true; bf16_t* ACT; const PG8_LAS float* bias;
    __device__ __forceinline__ void operator()(const f32x4 (&acc)[2][2][4][2], const Unit& u, int wr, int wc, int fr, int fq) const {
        const int pnl = u.pn & 15, j0 = pnl * 128 + wc * 32 + 8 * fq;
        f32x4 bg[2], bu[2];
#pragma unroll
        for (int n = 0; n < 2; ++n) { bg[n] = *(const PG8_LAS f32x4*)(bias + u.ui * 256 + wc * 32 + 8 * fq + 4 * n); bu[n] = *(const PG8_LAS f32x4*)(bias + u.ui * 256 + 128 + wc * 32 + 8 * fq + 4 * n); }
#pragma unroll
        for (int ai = 0; ai < 2; ++ai)
#pragma unroll
            for (int m = 0; m < 4; ++m) { const int row = u.pm * BM + wr * 64 + fr + ai * HALF + m * 16; f32x4 o[2];
#pragma unroll
                for (int n = 0; n < 2; ++n) { f32x4 gt = acc[ai][0][m][n] + bg[n], up = acc[ai][1][m][n] + bu[n];
#pragma unroll
                    for (int q = 0; q < 4; ++q) { gt[q] = fminf(gt[q], 7.f); up[q] = fminf(fmaxf(up[q], -7.f), 7.f); }
                    f32x4 e = gt * (-1.702f * 1.4426950408889634f);
#pragma unroll
                    for (int q = 0; q < 4; ++q) e[q] = __builtin_amdgcn_exp2f(e[q]);
                    e = e + 1.0f;
#pragma unroll
                    for (int q = 0; q < 4; ++q) e[q] = __builtin_amdgcn_rcpf(e[q]);
                    o[n] = (up + 1.0f) * gt * e; }
                if constexpr (OUT8) { v2u w; w.x = pk4_fp8(o[0][0], o[0][1], o[0][2], o[0][3]); w.y = pk4_fp8(o[1][0], o[1][1], o[1][2], o[1][3]); *(v2u*)((unsigned char*)ACT + (size_t)row * DFF + j0) = w; }
                else *(u32x4*)(ACT + (size_t)row * DFF + j0) = pack8(o[0], o[1]); }
    } };
struct EpiMoeDn { static constexpr bool PERM = true; unsigned char* YM; const PG8_LAS float* bias;
    __device__ __forceinline__ void operator()(const f32x4 (&acc)[2][2][4][2], const Unit& u, int wr, int wc, int fr, int fq) const {
        const int pnl = u.pn & 7, col0 = pnl * BM + wc * 32 + 8 * fq;
        f32x4 bv[2][2];
#pragma unroll
        for (int bj = 0; bj < 2; ++bj)
#pragma unroll
            for (int n = 0; n < 2; ++n) bv[bj][n] = *(const PG8_LAS f32x4*)(bias + u.ui * 256 + bj * HALF + wc * 32 + 8 * fq + 4 * n);
        EPI_ROWS( const f32x4 v0 = (acc[ai][bj][m][0] + bv[bj][0]) * YM_SCALE, v1 = (acc[ai][bj][m][1] + bv[bj][1]) * YM_SCALE;
            v2u w; w.x = pk4_fp8(v0[0], v0[1], v0[2], v0[3]); w.y = pk4_fp8(v1[0], v1[1], v1[2], v1[3]);
            *(v2u*)(YM + (size_t)row * D + col0 + bj * HALF) = w; )
    } };
}

constexpr int NWAVES = 8;
#ifndef MK_N_LAUNCHES
#define MK_N_LAUNCHES 1
#endif
constexpr int PER_PHASE = 11;
#ifndef FP8_UP
#define FP8_UP 1
#endif
#ifndef FP8_DN
#define FP8_DN 1
#endif
constexpr bool kFp8Up = FP8_UP, kFp8Dn = FP8_DN;
constexpr float W8_SCALE = 64.f, W8_INV = 1.f / 64.f;
#ifndef NCONV
#define NCONV 64
#endif
constexpr int NCONV_WG = NCONV;
constexpr int N_LAUNCHES = MK_N_LAUNCHES;

constexpr size_t MiB = 1u << 20;
constexpr size_t WS_CTL = 0, CTL_ZERO_BYTES = 1 * MiB;
constexpr size_t WS_W1N = 1 * MiB;
constexpr size_t WS_WMG8 = WS_W1N + 16 * MiB;
constexpr size_t WS_W1V = WS_W1N + 32 * MiB;
constexpr size_t WS_WPA = WS_W1V + 8 * MiB;
constexpr size_t WS_WPB = WS_WPA + 4 * MiB;
constexpr size_t WS_WOT = WS_WPB + 4 * MiB;
constexpr size_t WS_WRH = WS_WOT + 8 * MiB;
constexpr size_t WS_WRL = WS_WRH + 128 * 1024;
constexpr size_t WS_WGU = WS_WRH + 1 * MiB;
constexpr size_t WS_WDN = WS_WGU + 512 * MiB;
constexpr size_t WS_H = WS_WDN + 256 * MiB;
constexpr size_t WS_AIF = WS_H + 64 * MiB;
constexpr size_t WS_QKO = WS_AIF + 1 * MiB;
constexpr size_t WS_GT = WS_QKO + 128 * MiB;
constexpr size_t WS_VT = WS_GT + 128 * MiB;
constexpr size_t WS_QC = WS_VT + 64 * MiB;
constexpr size_t WS_KC = WS_QC + 16 * MiB;
constexpr size_t WS_SC = WS_KC + 16 * MiB;
constexpr size_t SC_G = 4 * (size_t)M * 4, SC_MLOC = SC_G + 4096, SC_MPREV = SC_MLOC + 4096;
constexpr size_t WS_CLOC = WS_SC + 1 * MiB;
constexpr size_t WS_NLOC = WS_CLOC + 128 * MiB;
constexpr size_t WS_CPREV = WS_NLOC + 1 * MiB;
constexpr size_t WS_NPREV = WS_CPREV + 64 * MiB;
constexpr size_t WS_YA = WS_NPREV + 1 * MiB;
constexpr size_t WS_YB = WS_YA + 32 * MiB;
constexpr size_t WS_MIX = WS_YB + 32 * MiB;
constexpr size_t WS_X2 = WS_MIX + 64 * MiB;
constexpr size_t WS_H2 = WS_X2 + 128 * MiB;
constexpr size_t WS_H8 = WS_H2;
constexpr size_t WS_PE = WS_H2 + 64 * MiB;
constexpr size_t WS_PG = WS_PE + 256 * 1024;
constexpr size_t WS_LIST = WS_PG + 256 * 1024;
constexpr size_t WS_ACT = WS_LIST + 2 * MiB + 512 * 1024;
constexpr size_t WS_YM = WS_ACT + 288 * MiB;
constexpr size_t WS_END = WS_YM + 288 * MiB;
constexpr int CW_BAR = 4096;
constexpr int CW_Q = 12288;
constexpr int CW_CNT = 16384;

constexpr int RING_OFF = 0, RING_BYTES = 131072;
constexpr int TOK_OFF = RING_BYTES, MAX_UNITS = 18, TOK_BYTES = MAX_UNITS * 512;
constexpr int BIAS_OFF = TOK_OFF + TOK_BYTES, BIAS_BYTES = MAX_UNITS * 1024;
constexpr int UTAB_OFF = BIAS_OFF + BIAS_BYTES;
constexpr int TST_OFF = UTAB_OFF + 512;
constexpr int MISC_OFF = TST_OFF + 512;
constexpr int LDS_BYTES = MISC_OFF + 128;
static_assert(LDS_BYTES <= 163840, "LDS");

#define XB_TMO      128
#define XB_XCNT(j)  (256  + 64 * (j))
#define XB_XSUB(j)  (1280 + 64 * (j))
#define XB_XGEN(j)  (2304 + 64 * (j))
#define XB_TOP      3328
#define XB_TOPGEN   3392
#define XCD_BAR_WORDS 3456
#define XB_SPIN_CAP (1u << 22)
DI unsigned xb_ld(unsigned* p)              { return __hip_atomic_load(p, __ATOMIC_RELAXED, __HIP_MEMORY_SCOPE_AGENT); }
DI unsigned xb_add(unsigned* p, unsigned v) { return __hip_atomic_fetch_add(p, v, __ATOMIC_RELAXED, __HIP_MEMORY_SCOPE_AGENT); }
DI unsigned xb_xcc_id() { return (unsigned)__builtin_amdgcn_s_getreg((3 << 11) | 20) & 0xFu; }
#define XB_SPIN(cond, bar) do { unsigned _sp = 0; while (cond) { __builtin_amdgcn_s_sleep(1); \
    if ((++_sp & 255u) == 0u) { if (xb_ld(&(bar)[XB_TMO])) break; if (_sp > XB_SPIN_CAP) { atomicAdd(&(bar)[XB_TMO], 1u); break; } } } } while (0)
struct XcdBarrier { unsigned* bar; unsigned x; volatile LAS unsigned* st; };
DI XcdBarrier xcd_barrier_post(unsigned* bar, volatile LAS unsigned* st) {
    XcdBarrier b; b.bar = bar; b.x = xb_xcc_id(); b.st = st;
    if (threadIdx.x == 0) (void)xb_add(&bar[XB_XCNT(b.x)], 1u);
    return b;
}
DI void xcd_barrier_complete(unsigned* bar, unsigned x, unsigned& nloc, unsigned& nx) {
    const unsigned G = gridDim.x * gridDim.y * gridDim.z;
    unsigned sum, cnt, mine, sp = 0u;
    for (;;) {
        sum = 0u; cnt = 0u; mine = 0u;
#pragma unroll
        for (unsigned j = 0; j < 16; ++j) { const unsigned c = xb_ld(&bar[XB_XCNT(j)]); sum += c; cnt += (c > 0u) ? 1u : 0u; mine = (j == x) ? c : mine; }
        if (sum == G) break;
        __builtin_amdgcn_s_sleep(1);
        if ((++sp & 255u) == 0u) { if (xb_ld(&bar[XB_TMO])) break; if (sp > XB_SPIN_CAP) { atomicAdd(&bar[XB_TMO], 1u); break; } }
    }
    nloc = mine > 0u ? mine : 1u; nx = cnt > 0u ? cnt : 1u;
}
DI void xcd_barrier(const XcdBarrier& b) {
    asm volatile("s_waitcnt vmcnt(0)" ::: "memory");
    __syncthreads();
    if (threadIdx.x == 0) {
        unsigned* bar = b.bar;
        __builtin_amdgcn_s_waitcnt(0);
        unsigned nloc = b.st[0], nx = b.st[1];
        if (nloc == 0u) { xcd_barrier_complete(bar, b.x, nloc, nx); b.st[0] = nloc; b.st[1] = nx; }
        const unsigned old = xb_add(&bar[XB_XSUB(b.x)], 1u);
        const unsigned gen = old / nloc;
        if (old + 1u == (gen + 1u) * nloc) {
            __builtin_amdgcn_fence(__ATOMIC_RELEASE, "agent");
            asm volatile("s_waitcnt vmcnt(0)" ::: "memory");
            const unsigned og = xb_add(&bar[XB_TOP], 1u);
            const unsigned tg = og / nx;
            if (og + 1u == (tg + 1u) * nx) xb_add(&bar[XB_TOPGEN], 1u);
            else XB_SPIN(xb_ld(&bar[XB_TOPGEN]) == tg, bar);
            __builtin_amdgcn_fence(__ATOMIC_ACQUIRE, "agent");
            xb_add(&bar[XB_XGEN(b.x)], 1u);
            asm volatile("s_waitcnt vmcnt(0)" ::: "memory");
        } else {
            XB_SPIN(xb_ld(&bar[XB_XGEN(b.x)]) == gen, bar);
            __builtin_amdgcn_fence(__ATOMIC_ACQUIRE, "agent");
            asm volatile("s_waitcnt vmcnt(0)" ::: "memory");
        }
    }
    __syncthreads();
}

struct Frame {
    LAS unsigned char* lds;
    unsigned char* ws;
    gu32* ctl;
    int tid, lane, wave, G, bx;
    const float *x, *norm_mix, *w_in, *conv_w, *conv_b, *b_if, *norm_head, *w_pa, *w_pb, *w_mg, *b_mg, *w_out, *norm_ffn, *w_r, *b_r, *w_gu, *b_gu, *w_dn, *b_dn, *norm_final;
    float* out;
};
#define WSP(T, off) ((T*)(F.ws + (off)))

template <bool F8> DI void tr_item(const float* W, size_t pitch, size_t col0, int k0, void* WT, size_t drow0, int Kd, LAS unsigned char* scr, int lane) {
    constexpr int RB = F8 ? 128 : 256, PB = RB + 16;
    const int n4 = lane & 7, kr = lane >> 3;
    f32x4 v[16];
#pragma unroll
    for (int i = 0; i < 16; ++i) v[i] = __builtin_nontemporal_load((const GAS f32x4*)(W + (size_t)(k0 + 16 * kr + i) * pitch + col0 + 4 * n4));
#pragma unroll
    for (int q = 0; q < 4; ++q) { LAS unsigned char* rowp = scr + (q * 8 + n4) * PB + kr * (F8 ? 16 : 32);
        if constexpr (F8) { v4u o; o.x = pk4_fp8(v[0][q] * W8_SCALE, v[1][q] * W8_SCALE, v[2][q] * W8_SCALE, v[3][q] * W8_SCALE); o.y = pk4_fp8(v[4][q] * W8_SCALE, v[5][q] * W8_SCALE, v[6][q] * W8_SCALE, v[7][q] * W8_SCALE);
            o.z = pk4_fp8(v[8][q] * W8_SCALE, v[9][q] * W8_SCALE, v[10][q] * W8_SCALE, v[11][q] * W8_SCALE); o.w = pk4_fp8(v[12][q] * W8_SCALE, v[13][q] * W8_SCALE, v[14][q] * W8_SCALE, v[15][q] * W8_SCALE);
            *(LAS v4u*)rowp = o; }
        else { v4u o0, o1; o0.x = cvtpk(v[0][q], v[1][q]); o0.y = cvtpk(v[2][q], v[3][q]); o0.z = cvtpk(v[4][q], v[5][q]); o0.w = cvtpk(v[6][q], v[7][q]);
            o1.x = cvtpk(v[8][q], v[9][q]); o1.y = cvtpk(v[10][q], v[11][q]); o1.z = cvtpk(v[12][q], v[13][q]); o1.w = cvtpk(v[14][q], v[15][q]);
            *(LAS v4u*)rowp = o0; *(LAS v4u*)(rowp + 16) = o1; } }
    LDS_WAIT(); asm volatile("" ::: "memory");
    constexpr int CPR = RB / 16;
#pragma unroll
    for (int jj = 0; jj < (32 * CPR) / 64; ++jj) { const int idx = lane + 64 * jj, rho = idx / CPR, ch = idx % CPR, n = 4 * (rho & 7) + (rho >> 3);
        const v4u o = *(const LAS v4u*)(scr + rho * PB + 16 * ch);
        __builtin_nontemporal_store(o, (GAS v4u*)((unsigned char*)WT + ((drow0 + n) * (size_t)Kd + k0) * (F8 ? 1 : 2) + 16 * ch)); }
    LDS_WAIT(); asm volatile("" ::: "memory");
}
DI void p0_prologue(Frame& F) {
    LAS unsigned char* scr = F.lds + RING_OFF + F.wave * 8704;
    const int gw = F.bx * NWAVES + F.wave, NGW = F.G * NWAVES;
    bf16* W1N = WSP(bf16, WS_W1N); bf16* W1V = WSP(bf16, WS_W1V);
    constexpr int KB = D / 128;
    constexpr int I0 = KB * 32, I1 = KB * 32, I2 = KB * 64, I3 = KB * 128, I4 = KB * 32, I5 = KB * 32, I6 = 8 * 64, I7 = 8 * 64, I8 = KB * 64;
    constexpr int NSMALL = I0 + I1 + I2 + I3 + I4 + I5 + I6 + I7 + I8;
    for (int it = gw; it < NSMALL; it += NGW) {
        const float* W; size_t pitch, scol, drow; int ncols, K; bf16* WT; int r = it; bool f8 = false;
        if (r < I0) { f8 = kFp8Qk; W = F.w_in; pitch = INC; scol = 0; ncols = 1024; K = D; WT = W1N; drow = 0; }
        else if ((r -= I0) < I1) { f8 = kFp8Qk; W = F.w_in; pitch = INC; scol = 2048; ncols = 1024; K = D; WT = W1N; drow = 1024; }
        else if ((r -= I1) < I2) { f8 = kFp8Qk; W = F.w_in; pitch = INC; scol = 3080; ncols = 2048; K = D; WT = W1N; drow = 2048; }
        else if ((r -= I2) < I3) { f8 = true; W = F.w_mg; pitch = 4096; scol = 0; ncols = 4096; K = D; WT = WSP(bf16, WS_WMG8); drow = 0; }
        else if ((r -= I3) < I4) { W = F.w_in; pitch = INC; scol = 1024; ncols = 1024; K = D; WT = W1V; drow = 0; }
        else if ((r -= I4) < I5) { W = F.w_in; pitch = INC; scol = 5128; ncols = 1024; K = D; WT = W1V; drow = 1024; }
        else if ((r -= I5) < I6) { W = F.w_pa; pitch = D; scol = 0; ncols = 2048; K = 1024; WT = WSP(bf16, WS_WPA); drow = 0; }
        else if ((r -= I6) < I7) { W = F.w_pb; pitch = D; scol = 0; ncols = 2048; K = 1024; WT = WSP(bf16, WS_WPB); drow = 0; }
        else { r -= I7; f8 = kFp8Out; W = F.w_out; pitch = D; scol = 0; ncols = 2048; K = D; WT = WSP(bf16, WS_WOT); drow = 0; }
        const int nbl = ncols / 32, kb = r / nbl, nb = r % nbl, n0 = 32 * nb;
        if (f8) tr_item<true>(W, pitch, scol + n0, 128 * kb, WT, drow + n0, K, scr, F.lane); else tr_item<false>(W, pitch, scol + n0, 128 * kb, WT, drow + n0, K, scr, F.lane);
    }
    for (int i = (F.bx * 512 + F.tid); i < NE * D; i += F.G * 512) { const int e = i / D, k = i % D; const float w = F.norm_ffn[k] * F.w_r[k * NE + e];
        const bf16 hi = f2bf(w); WSP(bf16, WS_WRH)[i] = hi; WSP(bf16, WS_WRL)[i] = f2bf(w - bf2f(hi)); }
    __syncthreads();
    LAS float* wif = (LAS float*)(F.lds + RING_OFF);
#pragma unroll
    for (int ii = 0; ii < 8 * D / 512; ++ii) { const int i = F.tid + 512 * ii, k = i >> 3, j = i & 7; wif[j * D + k] = F.w_in[(size_t)k * INC + 3072 + j]; }
    __syncthreads();
    bf16* H = WSP(bf16, WS_H); float* AIF = WSP(float, WS_AIF);
    f32x4 g[8], vn[8];
    { const GAS f32x4* gr = (const GAS f32x4*)F.norm_mix + F.lane;
#pragma unroll
      for (int j = 0; j < 8; ++j) g[j] = gr[64 * j];
      const GAS f32x4* xr = (const GAS f32x4*)(F.x + (size_t)(gw < M ? gw : 0) * D) + F.lane;
#pragma unroll
      for (int j = 0; j < 8; ++j) vn[j] = xr[64 * j]; }
    for (int m = gw; m < M; m += NGW) {
        f32x4 v[8]; float ss = 0.f;
#pragma unroll
        for (int j = 0; j < 8; ++j) { v[j] = vn[j]; ss += (v[j].x * v[j].x + v[j].y * v[j].y) + (v[j].z * v[j].z + v[j].w * v[j].w); }
        { const int mn = (m + NGW < M) ? m + NGW : m; const GAS f32x4* xr = (const GAS f32x4*)(F.x + (size_t)mn * D) + F.lane;
#pragma unroll
          for (int j = 0; j < 8; ++j) vn[j] = xr[64 * j]; }
        const float rstd = 1.f / sqrtf(wave_sum(ss) * (1.f / D) + EPS);
        GAS v2u* o8 = (GAS v2u*)(H + (size_t)m * D) + F.lane; GAS unsigned* o4 = (GAS unsigned*)(F.ws + WS_H8 + (size_t)m * D) + F.lane;
#pragma unroll
        for (int j = 0; j < 8; ++j) { v[j] = v[j] * rstd * g[j]; v2u w; w.x = cvtpk(v[j].x, v[j].y); w.y = cvtpk(v[j].z, v[j].w); o8[64 * j] = w; o4[64 * j] = pk4_fp8(v[j].x, v[j].y, v[j].z, v[j].w); }
        float p[8];
#pragma unroll
        for (int q = 0; q < 8; ++q) { float a = 0.f;
#pragma unroll
            for (int j = 0; j < 8; ++j) { const f32x4 w = *(const LAS f32x4*)(wif + q * D + 4 * F.lane + 256 * j); a += (v[j].x * w.x + v[j].y * w.y) + (v[j].z * w.z + v[j].w * w.w); }
            p[q] = a; asm volatile("" ::: "memory"); }
        const bool b5 = (F.lane & 32) != 0, b4 = (F.lane & 16) != 0, b3 = (F.lane & 8) != 0;
        float r4[4], r2[2], r1;
#pragma unroll
        for (int i = 0; i < 4; ++i) { const float snd = b5 ? p[i] : p[i + 4], kp = b5 ? p[i + 4] : p[i]; r4[i] = kp + __shfl_xor(snd, 32); }
#pragma unroll
        for (int i = 0; i < 2; ++i) { const float snd = b4 ? r4[i] : r4[i + 2], kp = b4 ? r4[i + 2] : r4[i]; r2[i] = kp + __shfl_xor(snd, 16); }
        { const float snd = b3 ? r2[0] : r2[1], kp = b3 ? r2[1] : r2[0]; r1 = kp + __shfl_xor(snd, 8); }
        r1 += __shfl_xor(r1, 4); r1 += __shfl_xor(r1, 2); r1 += __shfl_xor(r1, 1);
        { const int q = (F.lane >> 3) & 7; const int qq = ((q & 4) ? 4 : 0) + ((q & 2) ? 2 : 0) + (q & 1);
          if ((F.lane & 7) == 0) AIF[(size_t)m * 8 + qq] = r1 + F.b_if[qq]; }
    }
}

constexpr int CONV_BATCH = 8;
DI void conv_queue(Frame& F) {
    LAS unsigned char* scr = F.lds + RING_OFF + F.wave * 8704;
    constexpr int KB = D / 128, IGU = KB * 128, IDN = KB * 64, IEX = IGU + IDN, NITEMS = NE * IEX;
    for (;;) {
        int base = 0; if (F.lane == 0) base = (int)__hip_atomic_fetch_add((unsigned*)(F.ctl + CW_Q), (unsigned)CONV_BATCH, RLX_AGENT);
        base = __builtin_amdgcn_readfirstlane(base);
        if (base >= NITEMS) break;
        for (int it = base; it < base + CONV_BATCH && it < NITEMS; ++it) {
            const int e = it / IEX; int r = it % IEX;
            if (r < IGU) { const int kb = r / 128, nb = r % 128, n0 = 32 * nb, np = n0 & 2047; const size_t dr = (size_t)(np / 128) * 256 + (n0 >= 2048 ? 128 : 0) + (np % 128);
                if (kFp8Up) tr_item<true>(F.w_gu + (size_t)e * D * 4096, 4096, n0, 128 * kb, F.ws + WS_WGU + (size_t)e * 4096 * D, dr, D, scr, F.lane);
                else tr_item<false>(F.w_gu + (size_t)e * D * 4096, 4096, n0, 128 * kb, F.ws + WS_WGU + (size_t)e * 4096 * D * 2, dr, D, scr, F.lane); }
            else { r -= IGU; const int kb = r / 64, nb = r % 64, n0 = 32 * nb;
                if (kFp8Dn) tr_item<true>(F.w_dn + (size_t)e * DFF * D, D, n0, 128 * kb, F.ws + WS_WDN + (size_t)e * D * DFF, n0, DFF, scr, F.lane);
                else tr_item<false>(F.w_dn + (size_t)e * DFF * D, D, n0, 128 * kb, F.ws + WS_WDN + (size_t)e * D * DFF * 2, n0, DFF, scr, F.lane); }
        }
    }
}

struct AttnCtx { const bf16* ksrc; const bf16* vsrc; LAS unsigned char* vimg; LAS unsigned char* qimg; int n, h, vr_, vc_; float CS; };
template <bool DIAG> DI void attn_block(const AttnCtx& A, int kn, const bf16x8 (&akc)[8], bf16x8 (&akn)[8], v4u (&vreg)[8], f32x16 (&o)[4], float& carry) {
    const int n = A.n, h = A.h;
#pragma unroll
    for (int i = 0; i < 8; ++i) *(LAS v4u*)(A.vimg + (A.vr_ + 16 * i) * 80 + 16 * A.vc_) = vreg[i];
#pragma unroll
    for (int i = 0; i < 8; ++i) vreg[i] = *(const GAS v4u*)(A.vsrc + (size_t)kn * 4096 + 512 * i);
    { const bf16* krow = A.ksrc + (size_t)(32 * kn) * 4096;
#pragma unroll
      for (int s = 0; s < 8; ++s) akn[s] = *(const GAS bf16x8*)(krow + 16 * s); }
    __builtin_amdgcn_sched_barrier(0);
    f32x16 sc; bf16x8 bqs[8];
#pragma unroll
    for (int r = 0; r < 16; ++r) sc[r] = 0.f;
#pragma unroll
    for (int s = 0; s < 8; ++s) bqs[s] = *(const LAS bf16x8*)(A.qimg + n * 272 + 32 * s + 16 * h);
    __builtin_amdgcn_sched_barrier(0);
#pragma unroll
    for (int s = 0; s < 8; ++s) sc = MFMA32(akc[s], bqs[s], sc);
    float bt[16], kp[16];
#pragma unroll
    for (int r = 0; r < 16; ++r) { const float z = sc[r] * A.CS, e = __builtin_amdgcn_exp2f(-fabsf(z)), d = __builtin_amdgcn_rcpf(1.f + e), ed = e * d;
        float b_ = z >= 0.f ? d : ed, k_ = z >= 0.f ? ed : d;
        if (DIAG && !(crow(r, h) < n)) { b_ = 0.f; k_ = 1.f; }
        bt[r] = b_; kp[r] = k_; }
    float Gs[4], Go[4], T[4];
#pragma unroll
    for (int g = 0; g < 4; ++g) { Gs[g] = (kp[4 * g] * kp[4 * g + 1]) * (kp[4 * g + 2] * kp[4 * g + 3]); Go[g] = __shfl_xor(Gs[g], 32); T[g] = Gs[g] * Go[g]; }
    float tail[4]; tail[3] = 1.f; tail[2] = T[3]; tail[1] = T[3] * T[2]; tail[0] = tail[1] * T[1];
    float att[16];
#pragma unroll
    for (int g = 0; g < 4; ++g) { float R = carry * tail[g] * (h == 0 ? Go[g] : 1.f);
#pragma unroll
        for (int i = 3; i >= 0; --i) { att[4 * g + i] = bt[4 * g + i] * R; R *= kp[4 * g + i]; } }
    carry *= tail[0] * T[0];
    bf16x4 vlo[4][2], vhi[4][2];
#pragma unroll
    for (int dt = 0; dt < 4; ++dt)
#pragma unroll
        for (int s = 0; s < 2; ++s) { const LAS unsigned char* vp = A.vimg + (32 * dt + n) * 80 + 32 * s + 8 * h;
            vlo[dt][s] = *(const LAS bf16x4*)vp; vhi[dt][s] = *(const LAS bf16x4*)(vp + 16); }
    __builtin_amdgcn_sched_barrier(0);
    bf16x8 pf[2];
#pragma unroll
    for (int s = 0; s < 2; ++s) { v4u w; w.x = cvtpk(att[8 * s], att[8 * s + 1]); w.y = cvtpk(att[8 * s + 2], att[8 * s + 3]); w.z = cvtpk(att[8 * s + 4], att[8 * s + 5]); w.w = cvtpk(att[8 * s + 6], att[8 * s + 7]);
        pf[s] = __builtin_bit_cast(bf16x8, w); }
#pragma unroll
    for (int dt = 0; dt < 4; ++dt)
#pragma unroll
        for (int s = 0; s < 2; ++s) { const bf16x8 av = __builtin_shufflevector(vlo[dt][s], vhi[dt][s], 0, 1, 2, 3, 4, 5, 6, 7);
            o[dt] = MFMA32(av, pf[s], o[dt]); }
}
DI void attn_wave_unit(const bf16* QKO, const bf16* VT, bf16* YB, int hd, int qt, int lane, LAS unsigned char* vimg) {
    const int n = lane & 31, h = lane >> 5, t0 = 32 * qt;
    AttnCtx A; A.n = n; A.h = h; A.vr_ = lane >> 2; A.vc_ = lane & 3; A.vimg = vimg; A.qimg = vimg + 10240;
    A.CS = 0.08838834764831845f * 1.4426950408889634f;
    A.vsrc = VT + VT_B + (size_t)hd * 512 * 4096 + A.vr_ * 32 + 8 * A.vc_;
    A.ksrc = QKO + (size_t)n * 4096 + 3072 + hd * 128 + 8 * h;
    { const bf16* qrow = QKO + (size_t)(t0 + n) * 4096 + 2048 + hd * 128 + 8 * h;
#pragma unroll
      for (int s = 0; s < 8; ++s) *(LAS bf16x8*)(A.qimg + n * 272 + 32 * s + 16 * h) = *(const GAS bf16x8*)(qrow + 16 * s); }
    f32x16 o[4];
#pragma unroll
    for (int d = 0; d < 4; ++d)
#pragma unroll
        for (int r = 0; r < 16; ++r) o[d][r] = 0.f;
    float carry = 1.f;
    bf16x8 akA[8], akB[8]; v4u vreg[8];
    { const bf16* krow = A.ksrc + (size_t)(32 * qt) * 4096;
#pragma unroll
      for (int s = 0; s < 8; ++s) akA[s] = *(const GAS bf16x8*)(krow + 16 * s);
#pragma unroll
      for (int i = 0; i < 8; ++i) vreg[i] = *(const GAS v4u*)(A.vsrc + (size_t)qt * 4096 + 512 * i); }
    int kb = qt;
    attn_block<true>(A, kb > 0 ? kb - 1 : 0, akA, akB, vreg, o, carry);
    while (kb > 0 && !__all(carry == 0.f)) {
        --kb; attn_block<false>(A, kb > 0 ? kb - 1 : 0, akB, akA, vreg, o, carry);
        if (kb == 0 || __all(carry == 0.f)) break;
        --kb; attn_block<false>(A, kb > 0 ? kb - 1 : 0, akA, akB, vreg, o, carry);
    }
    bf16* yrow = YB + (size_t)(t0 + n) * 1024 + hd * 128 + 4 * h;
#pragma unroll
    for (int dt = 0; dt < 4; ++dt)
#pragma unroll
        for (int g = 0; g < 4; ++g) { v2u w; w.x = cvtpk(o[dt][4 * g], o[dt][4 * g + 1]); w.y = cvtpk(o[dt][4 * g + 2], o[dt][4 * g + 3]); *(GAS v2u*)(yrow + 32 * dt + 8 * g) = w; }
}

DI void mlstm_a_unit(Frame& F, int hd, int c) {
    LAS float* sE = (LAS float*)(F.lds + RING_OFF);
    LAS float* sCW = (LAS float*)(F.lds + RING_OFF + 256);
    LAS bf16* sKeT = (LAS bf16*)(F.lds + RING_OFF + 8192);
    const int t0 = CH * c;
    const bf16* QKO = WSP(const bf16, WS_QKO); const float* AIF = WSP(const float, WS_AIF); const bf16* VT = WSP(const bf16, WS_VT);
    float* ACUM = WSP(float, WS_SC); float* GG = (float*)(F.ws + WS_SC + SC_G); float* MLOC = (float*)(F.ws + WS_SC + SC_MLOC);
    const int t = F.tid >> 3, cg = F.tid & 7, n = F.lane & 31, h = F.lane >> 5, w = F.wave;
    v4u cin[2][4][2];
#pragma unroll
    for (int which = 0; which < 2; ++which)
#pragma unroll
        for (int j = 0; j < 4; ++j) { const int tt = t0 + t - 3 + j; const bf16* rp = QKO + (size_t)(tt < 0 ? 0 : tt) * 4096 + which * 512 + hd * 128 + 16 * cg;
            v4u a = *(const GAS v4u*)rp, b = *(const GAS v4u*)(rp + 8);
            if (tt < 0) { a = (v4u){0u, 0u, 0u, 0u}; b = a; }
            cin[which][j][0] = a; cin[which][j][1] = b; }
    bf16x8 bv[4];
#pragma unroll
    for (int s = 0; s < 4; ++s) bv[s] = *(const GAS bf16x8*)(VT + ((((size_t)(hd * NCH + c) * 256 + 32 * w + n)) << 6) + 16 * s + 8 * h);
    {   float cwv[3];
#pragma unroll
        for (int q = 0; q < 3; ++q) { const int i = F.tid + 512 * q, j = (i >> 8) < 4 ? (i >> 8) : 4, cc = i & 255; const int gcol = (cc < 128) ? hd * 128 + cc : 512 + hd * 128 + (cc - 128);
            cwv[q] = (j < 4) ? F.conv_w[j * 1024 + gcol] : F.conv_b[gcol]; }
#pragma unroll
        for (int q = 0; q < 3; ++q) { const int i = F.tid + 512 * q; if (i < 5 * 256) sCW[i] = cwv[q]; } }
    if (F.wave == 0) {
        const int tl = F.lane; const float f = AIF[(size_t)(t0 + tl) * 8 + 4 + hd], ig = AIF[(size_t)(t0 + tl) * 8 + hd];
        float a = fminf(f, 0.f) - log1pf(__expf(-fabsf(f)));
#pragma unroll
        for (int o = 1; o < 64; o <<= 1) { const float v = __shfl_up(a, o); if (tl >= o) a += v; }
        const float g = __shfl(a, 63), wv = g - a + ig, ml = wave_max(wv);
        sE[tl] = __expf(wv - ml); ACUM[(size_t)hd * M + t0 + tl] = a;
        if (tl == 0) { GG[hd * NCH + c] = g; MLOC[hd * NCH + c] = ml; }
    }
    __syncthreads();
    {
        const float et = sE[t];
#pragma unroll
        for (int which = 0; which < 2; ++which) {
            float acc[16];
#pragma unroll
            for (int i = 0; i < 16; ++i) acc[i] = sCW[4 * 256 + which * 128 + 16 * cg + i];
#pragma unroll
            for (int j = 0; j < 4; ++j) { const v4u a = cin[which][j][0], b = cin[which][j][1];
                const unsigned ww[8] = {a.x, a.y, a.z, a.w, b.x, b.y, b.z, b.w};
#pragma unroll
                for (int i = 0; i < 8; ++i) { acc[2 * i] += sCW[j * 256 + which * 128 + 16 * cg + 2 * i] * bflo(ww[i]); acc[2 * i + 1] += sCW[j * 256 + which * 128 + 16 * cg + 2 * i + 1] * bfhi(ww[i]); } }
#pragma unroll
            for (int i = 0; i < 16; ++i) { acc[i] = acc[i] * sigmoidf_(acc[i]); if (which) acc[i] *= 0.08838834764831845f; }
            bf16* op = WSP(bf16, which ? WS_KC : WS_QC) + (size_t)(t0 + t) * 512 + hd * 128 + 16 * cg;
            v4u o0, o1; o0.x = cvtpk(acc[0], acc[1]); o0.y = cvtpk(acc[2], acc[3]); o0.z = cvtpk(acc[4], acc[5]); o0.w = cvtpk(acc[6], acc[7]);
            o1.x = cvtpk(acc[8], acc[9]); o1.y = cvtpk(acc[10], acc[11]); o1.z = cvtpk(acc[12], acc[13]); o1.w = cvtpk(acc[14], acc[15]);
            *(GAS v4u*)op = o0; *(GAS v4u*)(op + 8) = o1;
            if (which) {
#pragma unroll
                for (int i = 0; i < 16; ++i) sKeT[(16 * cg + i) * 72 + t] = f2bf(et * acc[i]); }
        }
    }
    __syncthreads();
    {
        bf16* cl = WSP(bf16, WS_CLOC) + (((size_t)(hd * 64 + ((32 * w + n) >> 2)) * NCH + c) * 512 + (n & 3) * 128);
        bf16x8 ka_[4][4];
#pragma unroll
        for (int kt = 0; kt < 4; ++kt)
#pragma unroll
            for (int s2 = 0; s2 < 4; ++s2) ka_[kt][s2] = *(const LAS bf16x8*)(sKeT + (32 * kt + n) * 72 + 16 * s2 + 8 * h);
        __builtin_amdgcn_sched_barrier(0);
#pragma unroll
        for (int kt = 0; kt < 4; ++kt) { f32x16 acc;
#pragma unroll
            for (int r = 0; r < 16; ++r) acc[r] = 0.f;
#pragma unroll
            for (int s2 = 0; s2 < 4; ++s2) acc = MFMA32(ka_[kt][s2], bv[s2], acc);
#pragma unroll
            for (int g = 0; g < 4; ++g) { v2u o; o.x = cvtpk(acc[4 * g], acc[4 * g + 1]); o.y = cvtpk(acc[4 * g + 2], acc[4 * g + 3]); *(GAS v2u*)(cl + 32 * kt + 8 * g + 4 * h) = o; } }
        if (F.tid < 128) { float sm = 0.f;
#pragma unroll
            for (int t8 = 0; t8 < 8; ++t8) { const v4u q = *(const LAS v4u*)(sKeT + F.tid * 72 + 8 * t8); sm += (bflo(q.x) + bfhi(q.x)) + (bflo(q.y) + bfhi(q.y)) + (bflo(q.z) + bfhi(q.z)) + (bflo(q.w) + bfhi(q.w)); }
            WSP(float, WS_NLOC)[(size_t)(hd * NCH + c) * 128 + F.tid] = sm; }
    }
    __syncthreads();
}

DI void mlstm_scan(Frame& F) {
    LAS float* sG = (LAS float*)(F.lds + RING_OFF); LAS float* sML = sG + 256; LAS float* sSo = sG + 512; LAS float* sSn = sG + 768;
    const float* GG = (const float*)(F.ws + WS_SC + SC_G); const float* MLOC = (const float*)(F.ws + WS_SC + SC_MLOC); float* MPREV = (float*)(F.ws + WS_SC + SC_MPREV);
    for (int hb = F.bx; hb < 256; hb += F.G) {
        const int hd = hb >> 6, part = hb & 63;
        if (F.tid < 256) { sG[F.tid] = GG[hd * NCH + F.tid]; sML[F.tid] = MLOC[hd * NCH + F.tid]; }
        __syncthreads();
        if (F.wave == 0) { const int l = F.lane; float ga[4], mla[4];
#pragma unroll
            for (int q = 0; q < 4; ++q) { ga[q] = sG[4 * l + q]; mla[q] = sML[4 * l + q]; }
            float A = ga[0], B = mla[0];
#pragma unroll
            for (int q = 1; q < 4; ++q) { B = fmaxf(B + ga[q], mla[q]); A += ga[q]; }
#pragma unroll
            for (int o = 1; o < 64; o <<= 1) { const float Ap = __shfl_up(A, o), Bp = __shfl_up(B, o); if (l >= o) { B = fmaxf(Bp + A, B); A = Ap + A; } }
            const float Ae = __shfl_up(A, 1), Be = __shfl_up(B, 1);
            float m = (l == 0) ? 0.f : fmaxf(Ae, Be);
#pragma unroll
            for (int q = 0; q < 4; ++q) { const int c = 4 * l + q; const float mn = fmaxf(ga[q] + m, mla[q]); sSo[c] = __expf(ga[q] + m - mn); sSn[c] = __expf(mla[q] - mn); if (part == 0) MPREV[hd * NCH + c] = m; m = mn; } }
        __syncthreads();
        if (F.tid < 128) {
            const bf16* cl = WSP(const bf16, WS_CLOC) + (size_t)(hd * 64 + part) * NCH * 512 + 4 * F.tid; bf16* cp = WSP(bf16, WS_CPREV) + (size_t)(hd * 64 + part) * NCH * 512 + 4 * F.tid;
            f32x4 C = {0.f, 0.f, 0.f, 0.f};
            for (int c0 = 0; c0 < NCH; c0 += 16) { v2u v[16];
#pragma unroll
                for (int i = 0; i < 16; ++i) v[i] = *(const GAS v2u*)(cl + (size_t)(c0 + i) * 512);
#pragma unroll
                for (int i = 0; i < 16; ++i) { v2u wq; wq.x = cvtpk(C.x, C.y); wq.y = cvtpk(C.z, C.w); *(GAS v2u*)(cp + (size_t)(c0 + i) * 512) = wq;
                    const f32x4 vf = {bflo(v[i].x), bfhi(v[i].x), bflo(v[i].y), bfhi(v[i].y)}; C = C * sSo[c0 + i] + vf * sSn[c0 + i]; } }
        } else if (F.tid < 256 && part == 0) {
            const int k = F.tid - 128; float N = 0.f; const float* nl = WSP(const float, WS_NLOC) + (size_t)hd * NCH * 128 + k; float* np = WSP(float, WS_NPREV) + (size_t)hd * NCH * 128 + k;
            for (int c0 = 0; c0 < NCH; c0 += 32) { float nv[32];
#pragma unroll
                for (int i = 0; i < 32; ++i) nv[i] = nl[(size_t)(c0 + i) * 128];
#pragma unroll
                for (int i = 0; i < 32; ++i) { np[(size_t)(c0 + i) * 128] = N; N = N * sSo[c0 + i] + nv[i] * sSn[c0 + i]; } }
        }
        __syncthreads();
    }
}

DI void mlstm_c_unit(Frame& F, int hd, int c) {
    LAS float* sB = (LAS float*)(F.lds + RING_OFF);
    LAS float* sMx = sB + 64; LAS float* sSi = sB + 128; LAS float* sEmt = sB + 192; LAS float* sQN = sB + 256;
    LAS float* sRS = sB + 320;
    LAS float* sSS = sB + 448;
    LAS bf16* sQs = (LAS bf16*)(F.lds + RING_OFF + 4096);
    LAS bf16* sP = (LAS bf16*)(F.lds + RING_OFF + 4096 + 64 * 136 * 2);
    const int t0 = CH * c, n = F.lane & 31, h = F.lane >> 5, w = F.wave;
    const bf16* QC = WSP(const bf16, WS_QC); const bf16* KC = WSP(const bf16, WS_KC); const bf16* VT = WSP(const bf16, WS_VT); const float* AIF = WSP(const float, WS_AIF);
    const float* ACUM = WSP(const float, WS_SC); const float* MPREV = (const float*)(F.ws + WS_SC + SC_MPREV);
    const bf16* QKO = WSP(const bf16, WS_QKO); bf16* YA = WSP(bf16, WS_YA);
    const float mprev = MPREV[hd * NCH + c];
    bf16x8 ac[8], av[4];
    { const bf16* cp = WSP(const bf16, WS_CPREV) + (((size_t)(hd * 64 + ((32 * w + n) >> 2)) * NCH + c) * 512 + (n & 3) * 128) + 8 * h; const bf16* vr = VT + ((((size_t)(hd * NCH + c) * 256 + 32 * w + n)) << 6) + 8 * h;
#pragma unroll
      for (int s = 0; s < 8; ++s) ac[s] = *(const GAS bf16x8*)(cp + 16 * s);
#pragma unroll
      for (int s = 0; s < 4; ++s) av[s] = *(const GAS bf16x8*)(vr + 16 * s); }
    v2u ow[2][4]; f32x4 nh[4];
#pragma unroll
    for (int g = 0; g < 4; ++g) { const int v0 = hd * 256 + 32 * w + 8 * g + 4 * h; nh[g] = *(const GAS f32x4*)(F.norm_head + v0);
#pragma unroll
        for (int tt = 0; tt < 2; ++tt) ow[tt][g] = *(const GAS v2u*)(QKO + (size_t)(t0 + 32 * tt + n) * 4096 + 1024 + v0); }
    const int si = w >> 1, ti = w & 1;
    bf16x8 ka[8], qb[8];
    v4u qch[4]; f32x4 npv[8];
    float ga = 0.f, gi = 0.f;
    if (w < 4) {
        if (si <= ti) { const bf16* kr = KC + (size_t)(t0 + 32 * si + n) * 512 + hd * 128 + 8 * h; const bf16* qr = QC + (size_t)(t0 + 32 * ti + n) * 512 + hd * 128 + 8 * h;
#pragma unroll
            for (int s = 0; s < 8; ++s) { ka[s] = *(const GAS bf16x8*)(kr + 16 * s); qb[s] = *(const GAS bf16x8*)(qr + 16 * s); } }
    } else {
        const int u = F.tid - 256, t = u >> 2, qd = u & 3;
        const bf16* qr = QC + (size_t)(t0 + t) * 512 + hd * 128 + 32 * qd; const float* np = WSP(const float, WS_NPREV) + (size_t)(hd * NCH + c) * 128 + 32 * qd;
#pragma unroll
        for (int j = 0; j < 4; ++j) { qch[j] = *(const GAS v4u*)(qr + 8 * j); npv[2 * j] = *(const GAS f32x4*)(np + 8 * j); npv[2 * j + 1] = *(const GAS f32x4*)(np + 8 * j + 4); }
        if (w == 4) { ga = ACUM[(size_t)hd * M + t0 + F.lane]; gi = AIF[(size_t)(t0 + F.lane) * 8 + hd]; }
    }
    if (w == 4) {
        const int t = F.lane; const float bq_ = gi - ga;
        float pm = bq_;
#pragma unroll
        for (int o = 1; o < 64; o <<= 1) { const float v = __shfl_up(pm, o); if (t >= o) pm = fmaxf(pm, v); }
        const float mx = fmaxf(mprev, pm);
        sB[t] = bq_; sMx[t] = mx; sSi[t] = __expf(mprev - mx); sEmt[t] = __expf(-ga - mx);
    }
    __syncthreads();
    if (w < 4) {
        f32x16 acc;
#pragma unroll
        for (int r = 0; r < 16; ++r) acc[r] = 0.f;
        if (si <= ti) {
#pragma unroll
            for (int s = 0; s < 8; ++s) acc = MFMA32(ka[s], qb[s], acc);
        }
        const int t = 32 * ti + n; const float mx = sMx[t]; float rs = 0.f;
#pragma unroll
        for (int g = 0; g < 4; ++g) { float p[4];
#pragma unroll
            for (int i = 0; i < 4; ++i) { const int sI = 32 * si + 8 * g + 4 * h + i; p[i] = (sI <= t) ? __expf(sB[sI] - mx) * acc[4 * g + i] : 0.f; rs += p[i]; }
            v2u wv; wv.x = cvtpk(p[0], p[1]); wv.y = cvtpk(p[2], p[3]); *(LAS v2u*)(sP + t * 72 + 32 * si + 8 * g + 4 * h) = wv; }
        rs += __shfl_xor(rs, 32);
        if (h == 0) sRS[si * 64 + t] = rs;
    } else {
        const int u = F.tid - 256, t = u >> 2, qd = u & 3; const float si_ = sSi[t];
        float dot = 0.f;
#pragma unroll
        for (int j = 0; j < 4; ++j) { const f32x4 n0 = npv[2 * j], n1 = npv[2 * j + 1];
            f32x4 q0, q1; pg8::unpack8(qch[j], q0, q1);
            dot += (q0.x * n0.x + q0.y * n0.y) + (q0.z * n0.z + q0.w * n0.w) + (q1.x * n1.x + q1.y * n1.y) + (q1.z * n1.z + q1.w * n1.w);
            *(LAS v4u*)(sQs + t * 136 + 32 * qd + 8 * j) = pg8::pack8(q0 * si_, q1 * si_); }
        dot += __shfl_xor(dot, 1); dot += __shfl_xor(dot, 2);
        if (qd == 0) sQN[t] = dot;
    }
    __syncthreads();
    {
        f32x16 acc[2];
#pragma unroll
        for (int tt = 0; tt < 2; ++tt) {
            bf16x8 bq_[8], bp_[4];
#pragma unroll
            for (int s = 0; s < 8; ++s) bq_[s] = *(const LAS bf16x8*)(sQs + (32 * tt + n) * 136 + 16 * s + 8 * h);
#pragma unroll
            for (int s = 0; s < 4; ++s) bp_[s] = *(const LAS bf16x8*)(sP + (32 * tt + n) * 72 + 16 * s + 8 * h);
            __builtin_amdgcn_sched_barrier(0);
#pragma unroll
            for (int r = 0; r < 16; ++r) acc[tt][r] = 0.f;
#pragma unroll
            for (int s = 0; s < 8; ++s) acc[tt] = MFMA32(ac[s], bq_[s], acc[tt]);
#pragma unroll
            for (int s = 0; s < 4; ++s) acc[tt] = MFMA32(av[s], bp_[s], acc[tt]);
        }
#pragma unroll
        for (int tt = 0; tt < 2; ++tt) { const int t = 32 * tt + n; const float den = sSi[t] * sQN[t] + sRS[t] + sRS[64 + t]; const float inv = 1.f / fmaxf(fabsf(den), sEmt[t]);
            float ss = 0.f;
#pragma unroll
            for (int r = 0; r < 16; ++r) { acc[tt][r] *= inv; ss += acc[tt][r] * acc[tt][r]; }
            ss += __shfl_xor(ss, 32);
            if (h == 0) sSS[w * 64 + t] = ss; }
        __syncthreads();
#pragma unroll
        for (int tt = 0; tt < 2; ++tt) { const int t = 32 * tt + n; float tot = 0.f;
#pragma unroll
            for (int q = 0; q < 8; ++q) tot += sSS[q * 64 + t];
            const float rn = 1.f / sqrtf(tot * (1.f / 256.f) + EPS);
#pragma unroll
            for (int g = 0; g < 4; ++g) { const int v0 = hd * 256 + 32 * w + 8 * g + 4 * h; const v2u o_ = ow[tt][g];
                const float y0 = acc[tt][4 * g] * rn * nh[g].x * sigmoidf_(bflo(o_.x)), y1 = acc[tt][4 * g + 1] * rn * nh[g].y * sigmoidf_(bfhi(o_.x));
                const float y2 = acc[tt][4 * g + 2] * rn * nh[g].z * sigmoidf_(bflo(o_.y)), y3 = acc[tt][4 * g + 3] * rn * nh[g].w * sigmoidf_(bfhi(o_.y));
                v2u yw; yw.x = cvtpk(y0, y1); yw.y = cvtpk(y2, y3); *(GAS v2u*)(YA + (size_t)(t0 + t) * 1024 + v0) = yw; } }
    }
    __syncthreads();
}

DI void router_block(Frame& F, int rb) {
    LAS float* sLG = (LAS float*)(F.lds + RING_OFF);
    LAS float* sSSq = sLG + 4 * 64 * 33;
    LAS float* sRstd = sSSq + 256;
    LAS int* sCnt = (LAS int*)(sRstd + 64);
    LAS int* sBase = sCnt + 32;
    LAS int* sPE = sBase + 32;
    const int row0 = 64 * rb, n = F.lane & 31, h = F.lane >> 5;
    const bf16* X2 = WSP(const bf16, WS_X2);
    if (F.tid < 32) sCnt[F.tid] = 0;
    {   const int rt = F.wave >> 2, kq = F.wave & 3;
        const bf16* xr = X2 + (size_t)(row0 + 32 * rt + n) * D + 512 * kq + 8 * h;
        const bf16* wh = WSP(const bf16, WS_WRH) + (size_t)n * D + 512 * kq + 8 * h; const bf16* wl = WSP(const bf16, WS_WRL) + (size_t)n * D + 512 * kq + 8 * h;
        f32x16 acc;
#pragma unroll
        for (int r = 0; r < 16; ++r) acc[r] = 0.f;
        float ss = 0.f;
#pragma unroll 1
        for (int s0 = 0; s0 < 32; s0 += 8) {
            v4u xw[8]; bf16x8 bh[8], bl[8];
#pragma unroll
            for (int i = 0; i < 8; ++i) { xw[i] = *(const GAS v4u*)(xr + 16 * (s0 + i)); bh[i] = *(const GAS bf16x8*)(wh + 16 * (s0 + i)); bl[i] = *(const GAS bf16x8*)(wl + 16 * (s0 + i)); }
            __builtin_amdgcn_sched_barrier(0);
#pragma unroll
            for (int i = 0; i < 8; ++i) { f32x4 x0, x1; pg8::unpack8(xw[i], x0, x1);
                ss += (x0.x * x0.x + x0.y * x0.y) + (x0.z * x0.z + x0.w * x0.w) + (x1.x * x1.x + x1.y * x1.y) + (x1.z * x1.z + x1.w * x1.w);
                const bf16x8 ah = __builtin_bit_cast(bf16x8, xw[i]);
                acc = MFMA32(ah, bh[i], acc); acc = MFMA32(ah, bl[i], acc); }
        }
        ss += __shfl_xor(ss, 32);
        if (h == 0) sSSq[kq * 64 + 32 * rt + n] = ss;
#pragma unroll
        for (int r = 0; r < 16; ++r) sLG[(kq * 64 + 32 * rt + crow(r, h)) * 33 + n] = acc[r];
    }
    __syncthreads();
    int myE[4] = {0, 0, 0, 0}, myP[4] = {0, 0, 0, 0};
    {
#pragma unroll
        for (int q = 0; q < 4; ++q) { const int idx = F.tid + 512 * q, r = idx >> 5, e = idx & 31;
            const float ss = (sSSq[r] + sSSq[64 + r]) + (sSSq[128 + r] + sSSq[192 + r]); const float rstd = 1.f / sqrtf(ss * (1.f / D) + EPS); if (e == 0) sRstd[r] = rstd;
            sLG[r * 33 + e] = rstd * ((sLG[r * 33 + e] + sLG[(64 + r) * 33 + e]) + (sLG[(128 + r) * 33 + e] + sLG[(192 + r) * 33 + e])) + F.b_r[e]; } }
    __syncthreads();
    if (F.tid < 64) {
        const int r = F.tid;
        unsigned used = 0u; float tv[4];
#pragma unroll
        for (int k = 0; k < 4; ++k) { float best = -3.4e38f; int bi = 0;
            for (int e = 0; e < NE; ++e) { const float v = sLG[r * 33 + e]; if (!((used >> e) & 1u) && v > best) { best = v; bi = e; } }
            used |= 1u << bi; tv[k] = best; myE[k] = bi; }
        const float e1 = __expf(tv[1] - tv[0]), e2 = __expf(tv[2] - tv[0]), e3 = __expf(tv[3] - tv[0]), inv = 1.f / (1.f + e1 + e2 + e3);
        float* PG = WSP(float, WS_PG) + (size_t)(row0 + r) * 4; *(GAS f32x4*)PG = (f32x4){inv, e1 * inv, e2 * inv, e3 * inv};
#pragma unroll
        for (int k = 0; k < 4; ++k) myP[k] = atomicAdd((int*)&sCnt[myE[k]], 1);
    }
    __syncthreads();
    if (F.tid < 32) sBase[F.tid] = (int)__hip_atomic_fetch_add((unsigned*)(F.ctl + CW_CNT + 64 * F.tid), (unsigned)sCnt[F.tid], RLX_AGENT);
    __syncthreads();
    if (F.tid < 64) { int* PE = WSP(int, WS_PE) + (size_t)(row0 + F.tid) * 4; int* LIST = WSP(int, WS_LIST);
#pragma unroll
        for (int k = 0; k < 4; ++k) { const int pos = sBase[myE[k]] + myP[k]; PE[k] = myE[k] + 32 * pos; LIST[myE[k] * 16384 + pos] = row0 + F.tid; } }
    {
        f32x4 g[8]; { const GAS f32x4* gr = (const GAS f32x4*)F.norm_ffn + F.lane;
#pragma unroll
            for (int j = 0; j < 8; ++j) g[j] = gr[64 * j]; }
#pragma unroll 1
        for (int rr = 0; rr < 64 / NWAVES; rr += 4) {
            v2u xw[4][8]; float rs[4];
#pragma unroll
            for (int q = 0; q < 4; ++q) { const int r = F.wave + NWAVES * (rr + q); const GAS v2u* xr = (const GAS v2u*)(X2 + (size_t)(row0 + r) * D) + F.lane; rs[q] = sRstd[r];
#pragma unroll
                for (int j = 0; j < 8; ++j) xw[q][j] = xr[64 * j]; }
#pragma unroll
            for (int q = 0; q < 4; ++q) { const int r = F.wave + NWAVES * (rr + q);
                if (kFp8Up) { GAS unsigned* o4 = (GAS unsigned*)(F.ws + WS_H2 + (size_t)(row0 + r) * D) + F.lane;
#pragma unroll
                    for (int j = 0; j < 8; ++j) { const f32x4 v = (f32x4){bflo(xw[q][j].x), bfhi(xw[q][j].x), bflo(xw[q][j].y), bfhi(xw[q][j].y)} * rs[q] * g[j]; o4[64 * j] = pk4_fp8(v.x, v.y, v.z, v.w); } }
                else { GAS v2u* o8 = (GAS v2u*)(WSP(bf16, WS_H2) + (size_t)(row0 + r) * D) + F.lane;
#pragma unroll
                    for (int j = 0; j < 8; ++j) { const f32x4 v = (f32x4){bflo(xw[q][j].x), bfhi(xw[q][j].x), bflo(xw[q][j].y), bfhi(xw[q][j].y)} * rs[q] * g[j]; v2u w; w.x = cvtpk(v.x, v.y); w.y = cvtpk(v.z, v.w); o8[64 * j] = w; } }
            }
        }
    }
    __syncthreads();
}

DI int moe_plan(Frame& F, int NT, int gather, const float* bsrc) {
    LAS int* tst = (LAS int*)(F.lds + TST_OFF); LAS int* cntl = tst + 40; LAS int* utab = (LAS int*)(F.lds + UTAB_OFF); LAS unsigned short* tok = (LAS unsigned short*)(F.lds + TOK_OFF); LAS float* bias = (LAS float*)(F.lds + BIAS_OFF);
    if (F.wave == 0) {
        const int cv = (F.lane < 32) ? (int)__hip_atomic_load((unsigned*)(F.ctl + CW_CNT + 64 * (F.lane & 31)), RLX_AGENT) : 0, tl = (cv + 255) >> 8;
        int inc = tl;
#pragma unroll
        for (int o = 1; o < 32; o <<= 1) { const int v = __shfl_up(inc, o); if (F.lane >= o) inc += v; }
        if (F.lane < 32) { cntl[F.lane] = cv; tst[F.lane] = inc - tl; }
        if (F.lane == 31) tst[32] = inc; }
    __syncthreads();
    const int T = tst[32];
    const bool xm = (F.G == 256); const int xq = F.bx & 7, wq = F.bx >> 3, NJ = 256 / NT;
    const int joff = xm ? ((NT == 16) ? 4 * (xq >> 1) + (wq >> 3) : 4 * xq + (wq >> 3)) : 0, pfix = xm ? ((NT == 16) ? 8 * (xq & 1) + (wq & 7) : (wq & 7)) : 0;
    int nu = 0;
    if (xm) { while (nu < MAX_UNITS && NJ * nu + joff < T) ++nu; } else { for (long L = F.bx; L < (long)T * NT && nu < MAX_UNITS; L += F.G) ++nu; }
    if (F.tid < nu) { int j, pnl; if (xm) { j = NJ * F.tid + joff; pnl = pfix; } else { const int L = F.tid * F.G + F.bx; j = L / NT; pnl = L % NT; }
        int e = 0;
        for (int q = 1; q < NE; ++q) if (tst[q] <= j) e = q;
        utab[2 * F.tid] = j; utab[2 * F.tid + 1] = e * NT + pnl; utab[2 * MAX_UNITS + F.tid] = e; utab[3 * MAX_UNITS + F.tid] = (gather == 2) ? j * 256 : 0; }
    __syncthreads();
    const int* LIST = WSP(const int, WS_LIST);
    if (nu > 0) {
        constexpr int NIT = MAX_UNITS * 256 / 512;
        int tv[NIT]; float bv[NIT];
#pragma unroll
        for (int q = 0; q < NIT; ++q) { const int i0 = F.tid + 512 * q, i = (i0 < nu * 256) ? i0 : (F.tid & 255);
            const int ui = i >> 8, r = i & 255, j = utab[2 * ui], e = utab[2 * MAX_UNITS + ui], pnl = utab[2 * ui + 1] - e * NT;
            if (gather == 1) { const int pos = (j - tst[e]) * 256 + r, cnt = cntl[e]; const int t = LIST[e * 16384 + ((pos < cnt) ? pos : 0)]; tv[q] = (pos < cnt) ? t : 0;
                bv[q] = bsrc[(size_t)e * 4096 + (r < 128 ? 0 : 2048) + pnl * 128 + (r & 127)]; }
            else { tv[q] = r; bv[q] = bsrc[(size_t)e * D + pnl * 256 + r]; } }
#pragma unroll
        for (int q = 0; q < NIT; ++q) { const int i0 = F.tid + 512 * q; if (i0 < nu * 256) { tok[i0] = (unsigned short)tv[q]; bias[i0] = bv[q]; } }
    }
    VM_WAIT();
    __syncthreads();
    return nu;
}

DI void final_rows(Frame& F) {
    LAS int* tst = (LAS int*)(F.lds + TST_OFF); LAS int* cntl = tst + 40;
    if (F.wave == 0) {
        const int cv = (F.lane < 32) ? (int)__hip_atomic_load((unsigned*)(F.ctl + CW_CNT + 64 * (F.lane & 31)), RLX_AGENT) : 0, tl = (cv + 255) >> 8;
        int inc = tl;
#pragma unroll
        for (int o = 1; o < 32; o <<= 1) { const int v = __shfl_up(inc, o); if (F.lane >= o) inc += v; }
        if (F.lane < 32) { cntl[F.lane] = cv; tst[F.lane] = inc - tl; }
        if (F.lane == 31) tst[32] = inc; }
    __syncthreads();
    const int gw = F.bx * NWAVES + F.wave, NGW = F.G * NWAVES;
    const bf16* X2 = WSP(const bf16, WS_X2); const int* PE = WSP(const int, WS_PE); const float* PG = WSP(const float, WS_PG);
    f32x4 g[8]; v2u xn[8]; v4i pen; f32x4 pgn;
    { const GAS f32x4* gr = (const GAS f32x4*)F.norm_final + F.lane;
#pragma unroll
      for (int j = 0; j < 8; ++j) g[j] = gr[64 * j];
      const int m0 = gw < M ? gw : 0; const GAS v2u* xr = (const GAS v2u*)(X2 + (size_t)m0 * D) + F.lane;
#pragma unroll
      for (int j = 0; j < 8; ++j) xn[j] = xr[64 * j];
      pen = *(const GAS v4i*)(PE + (size_t)m0 * 4); pgn = *(const GAS f32x4*)(PG + (size_t)m0 * 4); }
    for (int m = gw; m < M; m += NGW) {
        f32x4 v[8]; const v4i pe4 = pen; const f32x4 pg4 = pgn;
#pragma unroll
        for (int j = 0; j < 8; ++j) v[j] = (f32x4){bflo(xn[j].x), bfhi(xn[j].x), bflo(xn[j].y), bfhi(xn[j].y)};
        unsigned yw[4][8];
#pragma unroll
        for (int k = 0; k < 4; ++k) { const int pe = __builtin_amdgcn_readfirstlane(pe4[k]); const int e = pe & 31, pos = pe >> 5;
            const GAS unsigned* yr = (const GAS unsigned*)(F.ws + WS_YM + ((size_t)tst[e] * 256 + pos) * D) + F.lane;
#pragma unroll
            for (int j = 0; j < 8; ++j) yw[k][j] = yr[64 * j]; }
        { const int mn = (m + NGW < M) ? m + NGW : m; const GAS v2u* xr = (const GAS v2u*)(X2 + (size_t)mn * D) + F.lane;
#pragma unroll
          for (int j = 0; j < 8; ++j) xn[j] = xr[64 * j];
          pen = *(const GAS v4i*)(PE + (size_t)mn * 4); pgn = *(const GAS f32x4*)(PG + (size_t)mn * 4); }
#pragma unroll
        for (int k = 0; k < 4; ++k) { const float gk = pg4[k] * YM_INV;
#pragma unroll
            for (int j = 0; j < 8; ++j) { const int w = (int)yw[k][j]; const f32x2 lo = __builtin_amdgcn_cvt_pk_f32_fp8(w, false), hi = __builtin_amdgcn_cvt_pk_f32_fp8(w, true);
                v[j].x += gk * lo.x; v[j].y += gk * lo.y; v[j].z += gk * hi.x; v[j].w += gk * hi.y; } }
        float ss = 0.f;
#pragma unroll
        for (int j = 0; j < 8; ++j) ss += (v[j].x * v[j].x + v[j].y * v[j].y) + (v[j].z * v[j].z + v[j].w * v[j].w);
        const float rstd = 1.f / sqrtf(wave_sum(ss) * (1.f / D) + EPS);
        GAS f32x4* orow = (GAS f32x4*)(F.out + (size_t)m * D) + F.lane;
#pragma unroll
        for (int j = 0; j < 8; ++j) orow[64 * j] = v[j] * rstd * g[j];
    }
}

struct Args { const float* in[20]; float* out; unsigned char* ws; int ph_lo, ph_hi, li, pad; };
__global__ void __launch_bounds__(NWAVES * 64, 2) mk_fwd(Args args) {
    extern __shared__ __attribute__((aligned(16))) unsigned char lds[];
    Frame F;
    F.lds = (LAS unsigned char*)lds; F.ws = args.ws; F.ctl = (gu32*)(args.ws + WS_CTL);
    F.tid = threadIdx.x; F.lane = F.tid & 63; F.wave = __builtin_amdgcn_readfirstlane(F.tid >> 6); F.G = gridDim.x; F.bx = blockIdx.x;
    F.x = args.in[0]; F.norm_mix = args.in[1]; F.w_in = args.in[2]; F.conv_w = args.in[3]; F.conv_b = args.in[4]; F.b_if = args.in[5]; F.norm_head = args.in[6]; F.w_pa = args.in[7]; F.w_pb = args.in[8];
    F.w_mg = args.in[9]; F.b_mg = args.in[10]; F.w_out = args.in[11]; F.norm_ffn = args.in[12]; F.w_r = args.in[13]; F.b_r = args.in[14]; F.w_gu = args.in[15]; F.b_gu = args.in[16]; F.w_dn = args.in[17];
    F.b_dn = args.in[18]; F.norm_final = args.in[19]; F.out = args.out;
    volatile LAS unsigned* MISC = (volatile LAS unsigned*)(F.lds + MISC_OFF);
    if (F.tid < 32) MISC[F.tid] = 0u;
    __syncthreads();
    XcdBarrier bar; bar.bar = (unsigned*)(F.ctl + CW_BAR); bar.x = 0; bar.st = nullptr;
    if (N_LAUNCHES != PER_PHASE) bar = xcd_barrier_post((unsigned*)(F.ctl + CW_BAR), MISC + 8);
#define GRID_BAR() do { if (N_LAUNCHES != PER_PHASE) xcd_barrier(bar); } while (0)
    const int lo = args.ph_lo, hi = args.ph_hi;
#ifndef PHMASK
#define PHMASK 0x7ff
#endif
#define IN(k) (((PHMASK >> (k)) & 1) && lo <= (k) && (k) < hi)
#define BOTH(k) (IN(k) && IN((k) + 1))
#ifndef DUP_MASK
#define DUP_MASK 0
#endif
#define REPS(k) (((DUP_MASK >> (k)) & 1) ? 2 : 1)
#define PH_BEGIN(k) if (IN(k)) { _Pragma("unroll") for (int rep_ = 0; rep_ < REPS(k); ++rep_) {
#define PH_END(k) if (BOTH(k) || rep_ + 1 < REPS(k)) GRID_BAR(); } }

    PH_BEGIN(0) p0_prologue(F); PH_END(0)

    PH_BEGIN(1)
        if (F.bx >= NCONV_WG && F.G > NCONV_WG) { const int Gg = F.G - NCONV_WG, cg = F.bx - NCONV_WG;
#define P1_QKO() { pg8::Gemm g{kFp8Qk ? WSP(const bf16, WS_H8) : WSP(const bf16, WS_H), WSP(const bf16, WS_W1N), M, 4096, kFp8Qk ? D / 2 : D}; pg8::StaticOrder S; S.init(M, 4096, Gg, cg); S.rowbytes = kFp8Qk ? D : 2 * D; \
          pg8::EpiPlain E{WSP(bf16, WS_QKO), 4096}; \
          if constexpr (kFp8Qk) pg8::gemm_phase<pg8::EpiPlain, pg8::StaticOrder, true, true, true>(F.lds + RING_OFF, g, S, E); \
          else pg8::gemm_phase<pg8::EpiPlain, pg8::StaticOrder, true, false>(F.lds + RING_OFF, g, S, E); }
#define P1_GATE() { pg8::Gemm g{WSP(const bf16, WS_H8), WSP(const bf16, WS_WMG8), M, 4096, D / 2}; pg8::StaticOrder S; S.init(M, 4096, Gg, cg); S.rowbytes = D; \
          pg8::EpiGate E{WSP(bf16, WS_GT), F.b_mg}; \
          pg8::gemm_phase<pg8::EpiGate, pg8::StaticOrder, true, true, true>(F.lds + RING_OFF, g, S, E); }
#define P1_VT() { pg8::Gemm g{WSP(const bf16, WS_W1V), WSP(const bf16, WS_H), 2048, M, D}; pg8::StaticOrder S; S.init(2048, M, Gg, cg); \
          pg8::EpiVT E{WSP(bf16, WS_VT)}; \
          pg8::gemm_phase<pg8::EpiVT, pg8::StaticOrder, true, false>(F.lds + RING_OFF, g, S, E); }
        if ((F.bx >> 3) & 1) { P1_GATE() P1_VT() P1_QKO() } else { P1_QKO() P1_GATE() P1_VT() }
#undef P1_QKO
#undef P1_GATE
#undef P1_VT
        }
        conv_queue(F);
    PH_END(1)

    PH_BEGIN(2)
        for (int u = F.bx; u < 4 * NCH; u += F.G) mlstm_a_unit(F, u >> 8, u & 255);
        { const int gw = F.bx * NWAVES + F.wave, NGW = F.G * NWAVES;
          for (int u = gw; u < 8 * (M / 32); u += NGW) attn_wave_unit(WSP(const bf16, WS_QKO), WSP(const bf16, WS_VT), WSP(bf16, WS_YB), u / (M / 32), u % (M / 32), F.lane, F.lds + RING_OFF + F.wave * 18944); }
    PH_END(2)

    PH_BEGIN(3) mlstm_scan(F); PH_END(3)

    PH_BEGIN(4) for (int u = F.bx; u < 4 * NCH; u += F.G) mlstm_c_unit(F, u >> 8, u & 255); PH_END(4)

    PH_BEGIN(5)
        { pg8::Gemm g{WSP(const bf16, WS_YA), WSP(const bf16, WS_WPA), M, D, 1024}; pg8::StaticOrder S; S.init(M, D, F.G, F.bx);
          pg8::EpiMix<false> E{WSP(bf16, WS_MIX), WSP(bf16, WS_X2 + 64 * MiB), WSP(const bf16, WS_GT), 0};
          pg8::gemm_phase<pg8::EpiMix<false>, pg8::StaticOrder, true, false>(F.lds + RING_OFF, g, S, E); }
        { pg8::Gemm g{WSP(const bf16, WS_YB), WSP(const bf16, WS_WPB), M, D, 1024}; pg8::StaticOrder S; S.init(M, D, F.G, F.bx);
          pg8::EpiMix<true> E{WSP(bf16, WS_MIX), WSP(bf16, WS_X2 + 64 * MiB), WSP(const bf16, WS_GT), 8};
          pg8::gemm_phase<pg8::EpiMix<true>, pg8::StaticOrder, true, false>(F.lds + RING_OFF, g, S, E); }
    PH_END(5)

    PH_BEGIN(6)
        pg8::Gemm g{WSP(const bf16, WS_MIX), WSP(const bf16, WS_WOT), M, D, kFp8Out ? D / 2 : D}; pg8::StaticOrder S; S.init(M, D, F.G, F.bx); S.rowbytes = kFp8Out ? D : 2 * D;
        pg8::EpiX2 E{F.x, WSP(bf16, WS_X2)};
        if constexpr (kFp8Out) pg8::gemm_phase<pg8::EpiX2, pg8::StaticOrder, true, true, true>(F.lds + RING_OFF, g, S, E);
        else pg8::gemm_phase<pg8::EpiX2, pg8::StaticOrder, true, false>(F.lds + RING_OFF, g, S, E);
    PH_END(6)

    PH_BEGIN(7) for (int rb = F.bx; rb < M / 64; rb += F.G) router_block(F, rb); PH_END(7)

    PH_BEGIN(8)
        const int nu = moe_plan(F, 16, 1, F.b_gu);
        pg8::Gemm g{WSP(const bf16, WS_H2), WSP(const bf16, WS_WGU), M, 4096, kFp8Up ? D / 2 : D};
        pg8::MoeOrder S{(const LAS int*)(F.lds + UTAB_OFF), (const LAS unsigned short*)(F.lds + TOK_OFF), __builtin_amdgcn_readfirstlane(nu), kFp8Up ? (unsigned)D : 2u * D, MAX_UNITS};
        pg8::EpiMoeUp<kFp8Dn> E{WSP(bf16, WS_ACT), (const LAS float*)(F.lds + BIAS_OFF)};
        pg8::gemm_phase<pg8::EpiMoeUp<kFp8Dn>, pg8::MoeOrder, true, true, kFp8Up>(F.lds + RING_OFF, g, S, E);
    PH_END(8)

    PH_BEGIN(9)
        const int nu = moe_plan(F, 8, 2, F.b_dn);
        pg8::Gemm g{WSP(const bf16, WS_ACT), WSP(const bf16, WS_WDN), ACT_ROWS, D, kFp8Dn ? DFF / 2 : DFF};
        pg8::MoeOrder S{(const LAS int*)(F.lds + UTAB_OFF), (const LAS unsigned short*)(F.lds + TOK_OFF), __builtin_amdgcn_readfirstlane(nu), kFp8Dn ? (unsigned)DFF : 2u * DFF, MAX_UNITS};
        pg8::EpiMoeDn E{F.ws + WS_YM, (const LAS float*)(F.lds + BIAS_OFF)};
        pg8::gemm_phase<pg8::EpiMoeDn, pg8::MoeOrder, true, true, kFp8Dn>(F.lds + RING_OFF, g, S, E);
    PH_END(9)

    PH_BEGIN(10) final_rows(F); PH_END(10)
#undef IN
#undef BOTH
}

extern "C" void kernel_launch(void* const* d_in, const int* in_sizes, int n_in, void* d_out, int out_size, void* d_ws, size_t ws_size, hipStream_t stream) {
    static int grid = 0;
    if (grid == 0) {
        if (n_in != 20 || out_size != M * D || ws_size < WS_END) { fprintf(stderr, "kernel_launch: unexpected problem (n_in %d, out %d, ws %zu < %zu)\n", n_in, out_size, ws_size, (size_t)WS_END); grid = -1; return; }
        int dev = 0, cus = 0, per_cu = 0;
        if (hipGetDevice(&dev) != hipSuccess || hipDeviceGetAttribute(&cus, hipDeviceAttributeMultiprocessorCount, dev) != hipSuccess) { grid = -1; return; }
        if (hipFuncSetAttribute((const void*)mk_fwd, hipFuncAttributeMaxDynamicSharedMemorySize, LDS_BYTES) != hipSuccess) { fprintf(stderr, "kernel_launch: hipFuncSetAttribute failed\n"); grid = -1; return; }
        if (hipOccupancyMaxActiveBlocksPerMultiprocessor(&per_cu, (const void*)mk_fwd, NWAVES * 64, LDS_BYTES) != hipSuccess || per_cu < 1) { fprintf(stderr, "kernel_launch: occupancy query reports %d\n", per_cu); }
        (void)hipGetLastError();
        grid = cus;
        if (grid > 256) grid = 256;
    }
    if (grid < 0) return;
    (void)hipMemsetAsync((char*)d_ws + WS_CTL, 0, CTL_ZERO_BYTES, stream);
    Args a{};
    for (int i = 0; i < 20; ++i) a.in[i] = (const float*)d_in[i];
    a.out = (float*)d_out; a.ws = (unsigned char*)d_ws;
    if (N_LAUNCHES == 1) { a.ph_lo = 0; a.ph_hi = PER_PHASE; a.li = 0; hipLaunchKernelGGL(mk_fwd, dim3(grid), dim3(NWAVES * 64), LDS_BYTES, stream, a); }
    else for (int li = 0; li < PER_PHASE; ++li) { a.ph_lo = li; a.ph_hi = li + 1; a.li = li; hipLaunchKernelGGL(mk_fwd, dim3(grid), dim3(NWAVES * 64), LDS_BYTES, stream, a); }
    const hipError_t le = hipPeekAtLastError();
    if (le != hipSuccess) fprintf(stderr, "kernel_launch: launch failed: %s\n", hipGetErrorName(le));
}
```
